# Optimizing an MI355X kernel written in HIP

```python
import math
import jax, jax.numpy as jnp
from jax import lax
import numpy as np

D_MODEL = 1024
BATCH = 16
SEQ = 4096
DEPTH = 2
DEC_BATCH = 16
DEC_SEQ = 2048
PAST_LEN = 128

HEAD_DIM = 64
N_HEADS_ATTN = 6
ATTN_WIDTH = N_HEADS_ATTN * HEAD_DIM
CONV_WIDTH = 256
N_HEADS_RWKV = 6
RWKV_WIDTH = N_HEADS_RWKV * HEAD_DIM
MIX_WIDTH = ATTN_WIDTH + CONV_WIDTH + RWKV_WIDTH
DECAY_RANK = 32
ICLR_RANK = 32
GATE_RANK = 64
RWKV_IN = 3 * RWKV_WIDTH + DECAY_RANK + ICLR_RANK + GATE_RANK
IN_WIDTH = 3 * ATTN_WIDTH + 3 * CONV_WIDTH + RWKV_IN
D_FF = 4 * D_MODEL
DILATED_PATTERNS = ((128, 1), (512, 4), (2048, 16))
QUERY_BLOCK = 64
N_BUCKETS = 32
BUCKET_MAX_DIST = 1024
RMS_EPS = 1e-6
LNX_EPS = 64e-5

kernel_name = "hybrid_dilated_conv_rwkv7_encoder"


def rms_norm(x, g):
    xf = x.astype(jnp.float32)
    y = xf * lax.rsqrt(jnp.mean(xf * xf, axis=-1, keepdims=True) + RMS_EPS)
    return (y * g.astype(jnp.float32)).astype(x.dtype)


def t5_bucket(rel):
    half = N_BUCKETS // 2
    max_exact = half // 2
    ret = np.where(rel > 0, half, 0)
    n = np.abs(rel)
    large = max_exact + (np.log(np.maximum(n, 1) / max_exact)
                         / np.log(BUCKET_MAX_DIST / max_exact) * (half - max_exact)).astype(np.int32)
    large = np.minimum(large, half - 1)
    return (ret + np.where(n < max_exact, n, large)).astype(np.int32)


def dilated_branch(q, k, v, rel_bias, window, dil):
    B, S, H, Dh = q.shape
    R = window // (2 * dil)
    L = S // dil
    qb = math.gcd(L, QUERY_BLOCK)
    nb = L // qb
    W = qb + 2 * R
    qc = q.reshape(B, nb, qb, dil, H, Dh)
    kp = jnp.pad(k.reshape(B, L, dil, H, Dh), ((0, 0), (R, R), (0, 0), (0, 0), (0, 0)))
    vp = jnp.pad(v.reshape(B, L, dil, H, Dh), ((0, 0), (R, R), (0, 0), (0, 0), (0, 0)))
    win = np.arange(nb)[:, None] * qb + np.arange(W)[None, :]
    kw = kp[:, win]
    vw = vp[:, win]
    logits = jnp.einsum('bnqchd,bnwchd->bnchqw', qc, kw).astype(jnp.float32) * (Dh ** -0.5)
    rel = np.arange(W)[None, :] - R - np.arange(qb)[:, None]
    bias = jnp.transpose(rel_bias[t5_bucket(rel * dil)], (2, 0, 1)).astype(jnp.float32)
    gidx = win - R
    valid = (np.abs(rel)[None] <= R) & (gidx[:, None, :] >= 0) & (gidx[:, None, :] < L)
    logits = jnp.where(valid[None, :, None, None], logits + bias, -jnp.inf)
    m = jnp.max(logits, axis=-1)
    p = jnp.exp(logits - m[..., None])
    s = jnp.sum(p, axis=-1)
    o = jnp.einsum('bnchqw,bnwchd->bnqchd', p, vw.astype(jnp.float32))
    m = jnp.transpose(m, (0, 1, 4, 2, 3)).reshape(B, S, H)
    s = jnp.transpose(s, (0, 1, 4, 2, 3)).reshape(B, S, H)
    o = o.reshape(B, S, H, Dh) / s[..., None]
    return m, s, o


def dilated_attention(q, k, v, rel_bias):
    outs = [dilated_branch(q, k, v, rel_bias, wnd, d) for (wnd, d) in DILATED_PATTERNS]
    m_all = jnp.stack([o[0] for o in outs])
    s_all = jnp.stack([o[1] for o in outs])
    o_all = jnp.stack([o[2] for o in outs])
    den = s_all * jnp.exp(m_all - jnp.max(m_all, axis=0))
    out = jnp.sum(den[..., None] * o_all, axis=0) / jnp.sum(den, axis=0)[..., None]
    return out.astype(q.dtype)


def short_conv_mixer(b_gate, c_gate, hv, conv_w):
    u = c_gate * hv
    up = jnp.pad(u, ((0, 0), (1, 1), (0, 0)))
    c = up[:, :-2] * conv_w[0] + up[:, 1:-1] * conv_w[1] + up[:, 2:] * conv_w[2]
    return b_gate * c


def centred_shift(z):
    zp = jnp.pad(z, ((0, 0), (1, 1), (0, 0)))
    return 0.5 * (zp[:, :-2] + zp[:, 2:])


def _wkv_step(S, inp):
    r, w, k, v, a_, b_ = inp
    sa = jnp.einsum('dbhij,dbhj->dbhi', S, a_)
    S = S * w[..., None, :] + sa[..., None] * b_[..., None, :] + v[..., None] * k[..., None, :]
    y = jnp.einsum('dbhij,dbhj->dbhi', S, r)
    return S, y


def rwkv7_mixer(zc, mu, w0, w_up, a0, a_up, g_up, k_k, k_a, r_k, lnx_w, lnx_b):
    dtype = zc.dtype
    B, T, _ = zc.shape
    H, N, C = N_HEADS_RWKV, HEAD_DIM, RWKV_WIDTH
    zc = zc.astype(jnp.float32)
    zc = zc + (centred_shift(zc) - zc) * mu
    r, k, v, wd, ad, gd = jnp.split(zc, [C, 2 * C, 3 * C, 3 * C + DECAY_RANK,
                                         3 * C + DECAY_RANK + ICLR_RANK], axis=-1)
    w_log = -jax.nn.softplus(-(w0[:, None, None, :]
                               + jnp.einsum('btr,drc->dbtc', jnp.tanh(wd), w_up))) - 0.5
    decay = jnp.exp(-jnp.exp(w_log))
    a = jax.nn.sigmoid(a0[:, None, None, :] + jnp.einsum('btr,drc->dbtc', ad, a_up))
    g = jax.nn.sigmoid(gd) @ g_up
    hd = lambda t: t.reshape(t.shape[:-1] + (H, N))
    kk = hd(k * k_k)
    kk = kk / jnp.maximum(jnp.sqrt(jnp.sum(kk * kk, axis=-1, keepdims=True)), 1e-12)
    k_dir = hd(k[None] * (1.0 + (a - 1.0) * k_a))
    b_dir = kk[None] * hd(a)
    r_h, v_h = hd(r), hd(v)

    def time_major(t_dir):
        t_dir = jnp.stack([t_dir[0], jnp.flip(t_dir[1], axis=1)])
        return jnp.transpose(t_dir, (2, 0, 1, 3, 4))

    both = lambda t: jnp.broadcast_to(t[None], (2,) + t.shape)
    xs = (time_major(both(r_h)), time_major(hd(decay)), time_major(k_dir),
          time_major(both(v_h)), time_major(both(-kk)), time_major(b_dir))
    S0 = jnp.zeros((2, B, H, N, N), jnp.float32)
    _, y = lax.scan(_wkv_step, S0, xs)
    y = y[:, 0] + jnp.flip(y[:, 1], axis=0)
    y = jnp.transpose(y, (1, 0, 2, 3))
    mean = jnp.mean(y, axis=-1, keepdims=True)
    var = jnp.mean(jnp.square(y - mean), axis=-1, keepdims=True)
    yn = (y - mean) * lax.rsqrt(var + LNX_EPS) * hd(lnx_w) + hd(lnx_b)
    bonus = jnp.sum(r_h[None] * k_dir * r_k, axis=(0, -1))[..., None] * v_h
    out = (yn + bonus).reshape(B, T, C) * g
    return out.astype(dtype)


def _layer(x, rel_bias, g_mix_pre, g_mix_post, g_ffn_pre, g_ffn_post, w_in, w_out,
           attn_out_g, conv_w, conv_out_g, rwkv_mu, decay_w0, decay_up, iclr_a0, iclr_up,
           gate_up, k_k, k_a, r_k, lnx_w, lnx_b, ffn_w1, ffn_w2):
    B, T, _ = x.shape
    h = rms_norm(x, g_mix_pre)
    z = h @ w_in
    o1 = 3 * ATTN_WIDTH
    o2 = o1 + 3 * CONV_WIDTH
    q, k, v = [t.reshape(B, T, N_HEADS_ATTN, HEAD_DIM) for t in jnp.split(z[..., :o1], 3, axis=-1)]
    b_gate, c_gate, hv = jnp.split(z[..., o1:o2], 3, axis=-1)
    zc = z[..., o2:]
    ya = rms_norm(dilated_attention(q, k, v, rel_bias).reshape(B, T, ATTN_WIDTH), attn_out_g)
    yb = rms_norm(short_conv_mixer(b_gate, c_gate, hv, conv_w), conv_out_g)
    yc = rwkv7_mixer(zc, rwkv_mu, decay_w0, decay_up, iclr_a0, iclr_up, gate_up,
                     k_k, k_a, r_k, lnx_w, lnx_b)
    mix = jnp.concatenate([ya, yb, yc], axis=-1) @ w_out
    x = x + rms_norm(mix, g_mix_post)
    hf = rms_norm(x, g_ffn_pre)
    f = jnp.square(jax.nn.relu(hf @ ffn_w1)) @ ffn_w2
    return x + rms_norm(f, g_ffn_post)


def _trunk(x, rel_bias, layer_params):
    for l in range(DEPTH):
        x = _layer(x, rel_bias, *[p[l] for p in layer_params])
    return x


def setup_inputs(seed: int = 0) -> dict:
    key = jax.random.key(seed)
    ks = jax.random.split(key, 32)
    n = lambda i, shape: jax.random.normal(ks[i], shape, jnp.float32)
    L = DEPTH
    return {
        "x_prompt": n(0, (BATCH, SEQ, D_MODEL)),
        "x_sample": n(1, (DEC_BATCH, DEC_SEQ, D_MODEL)),
        "rel_bias": 0.2 * n(2, (N_BUCKETS, N_HEADS_ATTN)),
        "norm_mix_pre": 1.0 + 0.05 * n(3, (L, D_MODEL)),
        "norm_mix_post": 1.0 + 0.05 * n(4, (L, D_MODEL)),
        "norm_ffn_pre": 1.0 + 0.05 * n(5, (L, D_MODEL)),
        "norm_ffn_post": 1.0 + 0.05 * n(6, (L, D_MODEL)),
        "w_in": n(7, (L, D_MODEL, IN_WIDTH)) * D_MODEL ** -0.5,
        "w_out": n(8, (L, MIX_WIDTH, D_MODEL)) * MIX_WIDTH ** -0.5,
        "attn_out_g": 1.0 + 0.05 * n(9, (L, ATTN_WIDTH)),
        "conv_w": n(10, (L, 3, CONV_WIDTH)) * 3 ** -0.5,
        "conv_out_g": 1.0 + 0.05 * n(11, (L, CONV_WIDTH)),
        "rwkv_mu": jax.random.uniform(ks[12], (L, RWKV_IN), jnp.float32),
        "decay_w0": jnp.linspace(-6.0, -0.5, RWKV_WIDTH, dtype=jnp.float32)[None, None, :]
                    + 0.3 * n(13, (L, 2, RWKV_WIDTH)),
        "decay_up": 0.1 * n(14, (L, 2, DECAY_RANK, RWKV_WIDTH)),
        "iclr_a0": 0.5 * n(15, (L, 2, RWKV_WIDTH)),
        "iclr_up": 0.5 * n(16, (L, 2, ICLR_RANK, RWKV_WIDTH)) * ICLR_RANK ** -0.5,
        "gate_up": n(17, (L, GATE_RANK, RWKV_WIDTH)) * GATE_RANK ** -0.5,
        "k_k": 0.85 + 0.1 * n(18, (L, RWKV_WIDTH)),
        "k_a": 1.0 + 0.1 * n(19, (L, RWKV_WIDTH)),
        "r_k": 0.1 * n(20, (L, N_HEADS_RWKV, HEAD_DIM)),
        "lnx_w": 1.0 + 0.05 * n(21, (L, RWKV_WIDTH)),
        "lnx_b": 0.02 * n(22, (L, RWKV_WIDTH)),
        "ffn_w1": n(23, (L, D_MODEL, D_FF)) * D_MODEL ** -0.5,
        "ffn_w2": n(24, (L, D_FF, D_MODEL)) * D_FF ** -0.5,
    }


def reference(x_prompt, x_sample, rel_bias, norm_mix_pre, norm_mix_post, norm_ffn_pre,
              norm_ffn_post, w_in, w_out, attn_out_g, conv_w, conv_out_g, rwkv_mu, decay_w0,
              decay_up, iclr_a0, iclr_up, gate_up, k_k, k_a, r_k, lnx_w, lnx_b, ffn_w1, ffn_w2):
    layer_params = (norm_mix_pre, norm_mix_post, norm_ffn_pre, norm_ffn_post, w_in, w_out,
                    attn_out_g, conv_w, conv_out_g, rwkv_mu, decay_w0, decay_up, iclr_a0,
                    iclr_up, gate_up, k_k, k_a, r_k, lnx_w, lnx_b, ffn_w1, ffn_w2)
    y_prompt = _trunk(x_prompt, rel_bias, layer_params)
    y_sample = _trunk(x_sample, rel_bias, layer_params)
    return (y_prompt, y_sample)
```

```cpp
#include <hip/hip_runtime.h>
#include <hip/hip_cooperative_groups.h>
#include <cstdio>
#include <cstdint>
namespace pg8 {
#define PG8_LAS __attribute__((address_space(3)))
typedef unsigned short bf16_t;
typedef short bf16x8 __attribute__((ext_vector_type(8)));
typedef float f32x4 __attribute__((ext_vector_type(4)));
typedef unsigned u32x4 __attribute__((ext_vector_type(4)));
constexpr int BM = 256, BK = 64, HALF = 128, HTB = HALF * BK * 2  , STAGE_BYTES = 8 * HTB, NXCD = 8, WGM = 8;

__host__ __device__ __forceinline__ int lds_byte(int r, int c) { const int st = (r >> 4) * 2 + (c >> 5), rr = r & 15, cc = c & 31, ob = rr * 64 + cc * 2; return st * 1024 + (ob ^ (((ob >> 9) & 1) << 5)); }
__host__ __device__ __forceinline__ void stage_rc(int b, int& R, int& C) { const int st = b / 1024, sb = b % 1024, swz = sb ^ (((sb >> 9) & 1) << 5); R = (st >> 1) * 16 + swz / 64; C = (st & 1) * 32 + (swz % 64) / 2; }
__host__ __device__ __forceinline__ int perm32(int rho) { const int n = rho >> 4, i = rho & 15; return 8 * (i >> 2) + 4 * n + (i & 3); }

struct Unit { int pm, pn; };
struct Gemm { const bf16_t* A; const bf16_t* Bt; int M, N, K; };

struct StaticOrder {
    int nM, nN, nwg, G, c;
    __host__ __device__ void init(int M, int N, int G_, int c_) { nM = M / BM; nN = N / BM; nwg = nM * nN; G = G_; c = c_; }
    __host__ __device__ bool next(int i, Unit& u) const {
        const long L = (long)i * G + c; if (L >= nwg) return false;
        int wgid = (int)L; { const int q = nwg / NXCD, r = nwg % NXCD, xcd = wgid % NXCD, off = wgid / NXCD; wgid = (xcd < r ? xcd * (q + 1) : r * (q + 1) + (xcd - r) * q) + off; }
        const int nig = WGM * nN, gid = wgid / nig, fm = gid * WGM, gsz = (nM - fm) < WGM ? (nM - fm) : WGM;
        u.pm = fm + ((wgid % nig) % gsz); u.pn = (wgid % nig) / gsz; return true;
    }
    __device__ __forceinline__ void a_ready(const Unit&) const {}
    __device__ __forceinline__ void done(const Unit&) const {}
};

__device__ __forceinline__ unsigned cvt_pk_bf16(float lo, float hi) { unsigned r; asm volatile("v_cvt_pk_bf16_f32 %0, %1, %2" : "=v"(r) : "v"(lo), "v"(hi)); return r; }
typedef float f32x2 __attribute__((ext_vector_type(2)));
__device__ __forceinline__ f32x2 gelu_pk(f32x2 v) {
    const f32x2 av = __builtin_elementwise_abs(v), d = av * 0.2316418882f + 1.0f;
    f32x2 t; t.x = __builtin_amdgcn_rcpf(d.x); t.y = __builtin_amdgcn_rcpf(d.y);
    f32x2 q = t * 0.5307027145f + (-0.7265760135f); q = q * t + 0.7107068705f; q = q * t + (-0.142248368f); q = q * t + 0.127414796f; q = q * t;
    const f32x2 s = (v * v) * (-0.72134752044f);
    f32x2 e; e.x = __builtin_amdgcn_exp2f(s.x); e.y = __builtin_amdgcn_exp2f(s.y);
    const f32x2 m = v * (q * e), r = v - m;
    f32x2 o; o.x = v.x < 0.f ? m.x : r.x; o.y = v.y < 0.f ? m.y : r.y; return o;
}

template <int ACT  > struct EpiBf16 {
    static constexpr bool PERM = true, AFTER_DRAIN = false; static_assert(ACT == 0 || ACT == 1, "EpiBf16: ACT is 0 (none) or 1 (gelu_pk)");
    bf16_t* O; int ldc; const float* bias; int split_cols; size_t split_stride; float scale0;
    __device__ __forceinline__ void operator()(const f32x4 (&acc)[2][2][4][2], const Unit& u, int wr, int wc, int fr, int fq) const {
        const int row0 = u.pm * BM + wr * 64 + fr; int colt = u.pn * BM; bf16_t* base = O;
        float sc = 1.f; if (split_cols) { const int t = colt / split_cols; base += (size_t)t * split_stride; colt -= t * split_cols; if (t == 0) sc = scale0; }
        const int col0 = colt + wc * 32 + 8 * fq, bcol0 = u.pn * BM + wc * 32 + 8 * fq;
        f32x4 bv[2][2];
#pragma unroll
        for (int bj = 0; bj < 2; ++bj)
#pragma unroll
            for (int n = 0; n < 2; ++n) bv[bj][n] = bias ? *(const f32x4*)(bias + bcol0 + bj * HALF + 4 * n) : (f32x4){0.f, 0.f, 0.f, 0.f};
#pragma unroll
        for (int ai = 0; ai < 2; ++ai)
#pragma unroll
            for (int m = 0; m < 4; ++m) { bf16_t* rowp = base + (size_t)(row0 + ai * HALF + m * 16) * ldc + col0;
#pragma unroll
                for (int bj = 0; bj < 2; ++bj) { f32x4 v0 = acc[ai][bj][m][0] + bv[bj][0], v1 = acc[ai][bj][m][1] + bv[bj][1];
                    if (ACT == 1) { f32x2 a = gelu_pk((f32x2){v0[0], v0[1]}), b = gelu_pk((f32x2){v0[2], v0[3]}), c = gelu_pk((f32x2){v1[0], v1[1]}), d = gelu_pk((f32x2){v1[2], v1[3]});
                        v0 = (f32x4){a.x, a.y, b.x, b.y}; v1 = (f32x4){c.x, c.y, d.x, d.y}; }
                    v0 = v0 * sc; v1 = v1 * sc; u32x4 w; w.x = cvt_pk_bf16(v0[0], v0[1]); w.y = cvt_pk_bf16(v0[2], v0[3]); w.z = cvt_pk_bf16(v1[0], v1[1]); w.w = cvt_pk_bf16(v1[2], v1[3]);
                    *(u32x4*)(rowp + bj * HALF) = w; } }
    }
};

template <int MODE> struct EpiMy {
    static constexpr bool PERM = true, AFTER_DRAIN = false;
    bf16_t* O; int ldc; int ncv; float* ssq;
    __device__ __forceinline__ void operator()(const f32x4 (&acc)[2][2][4][2], const Unit& u, int wr, int wc, int fr, int fq) const {
        const int row0 = u.pm * BM + wr * 64 + fr; const int col0 = u.pn * BM + wc * 32 + 8 * fq;
#pragma unroll
        for (int ai = 0; ai < 2; ++ai)
#pragma unroll
            for (int m = 0; m < 4; ++m) {
                const int row = row0 + ai * HALF + m * 16;
                bf16_t* rowp = O + (size_t)row * ldc + col0;
                float ss = 0.f;
#pragma unroll
                for (int bj = 0; bj < 2; ++bj) {
                    f32x4 v0 = acc[ai][bj][m][0], v1 = acc[ai][bj][m][1];
                    if (MODE == 1) {
#pragma unroll
                        for (int e = 0; e < 4; ++e) { const float a0 = fmaxf(v0[e], 0.f), a1 = fmaxf(v1[e], 0.f); v0[e] = a0 * a0; v1[e] = a1 * a1; }
                    }
                    if (MODE == 2) ss += (v0[0] * v0[0] + v0[1] * v0[1]) + (v0[2] * v0[2] + v0[3] * v0[3]) + (v1[0] * v1[0] + v1[1] * v1[1]) + (v1[2] * v1[2] + v1[3] * v1[3]);
                    u32x4 w; w.x = cvt_pk_bf16(v0[0], v0[1]); w.y = cvt_pk_bf16(v0[2], v0[3]); w.z = cvt_pk_bf16(v1[0], v1[1]); w.w = cvt_pk_bf16(v1[2], v1[3]);
                    if (col0 + bj * HALF < ncv) *(u32x4*)(rowp + bj * HALF) = w;
                }
                if (MODE == 2) { ss += __shfl_xor(ss, 16); ss += __shfl_xor(ss, 32); if (fq == 0) unsafeAtomicAdd(ssq + row, ss); }
            }
    }
};
template <class Epi, class Sched, bool ALIGN_EPI = false, bool SP2 = false>
__device__ __forceinline__ void gemm_phase(PG8_LAS unsigned char* lds, const Gemm g, const Sched& S, const Epi& E) {
    int tid_l_ = threadIdx.x; asm volatile("" : "+v"(tid_l_)); const int tid = tid_l_, wid = __builtin_amdgcn_readfirstlane(tid >> 6), lane = tid & 63, wr = wid >> 2, wc = wid & 3, fr = lane & 15, fq = lane >> 4;
    int Kl_ = g.K; asm volatile("" : "+s"(Kl_)); const int K = Kl_, nt = K / BK;
    unsigned voffA[2], voffB[2];
#pragma unroll
    for (int i = 0; i < 2; ++i) { int R, C; stage_rc(tid * 16 + i * 8192, R, C); const int Rb = Epi::PERM ? ((R & ~31) + perm32(R & 31)) : R;
        voffA[i] = (unsigned)(R * K + C) * 2u; voffB[i] = (unsigned)(Rb * K + C) * 2u; }
    const size_t kstep = (size_t)(BK * 2);
    const size_t hstep = (size_t)HALF * K * 2;
    const size_t tstep = 2 * hstep;
    const unsigned ldsw = (unsigned)wid * 1024u;
    const int aoff = lds_byte(wr * 64 + fr, fq * 8), boff = lds_byte(wc * 32 + fr, fq * 8);
#define PG8_SA(b, h) (((b) * 2 + (h)) * HTB)
#define PG8_SB(b, h) ((4 + (b) * 2 + (h)) * HTB)
#define PG8_STAGE(bufoff, gbase, voff) do { _Pragma("unroll") for (int _i = 0; _i < 2; ++_i) \
        __builtin_amdgcn_global_load_lds((const unsigned*)((const char*)(gbase) + (voff)[_i]), (PG8_LAS unsigned*)(lds + (bufoff) + ldsw + _i * 8192), 16, 0, 0); } while (0)
#define PG8_LDA(dst, b, h) do { _Pragma("unroll") for (int m = 0; m < 4; ++m) _Pragma("unroll") for (int k = 0; k < 2; ++k) dst[m][k] = *(const PG8_LAS bf16x8*)(lds + PG8_SA(b, h) + aoff + m * 2048 + k * 1024); } while (0)
#define PG8_LDB(dst, b, h) do { _Pragma("unroll") for (int n = 0; n < 2; ++n) _Pragma("unroll") for (int k = 0; k < 2; ++k) dst[n][k] = *(const PG8_LAS bf16x8*)(lds + PG8_SB(b, h) + boff + n * 2048 + k * 1024); } while (0)
#define PG8_MMA(ai, bj, At, Bt) do { __builtin_amdgcn_s_setprio(1); _Pragma("unroll") for (int m = 0; m < 4; ++m) _Pragma("unroll") for (int n = 0; n < 2; ++n) _Pragma("unroll") for (int k = 0; k < 2; ++k) \
        acc[ai][bj][m][n] = __builtin_amdgcn_mfma_f32_16x16x32_bf16(Bt[n][k], At[m][k], acc[ai][bj][m][n], 0, 0, 0); __builtin_amdgcn_s_setprio(0); } while (0)
#define PG8_WAIT_V(n) asm volatile("s_waitcnt vmcnt(" #n ")" ::: "memory")
#define PG8_WAIT_L(n) asm volatile("s_waitcnt lgkmcnt(" #n ")" ::: "memory")
#define PG8_BAR __builtin_amdgcn_s_barrier()
#define PG8_SCHED __builtin_amdgcn_sched_barrier(0)
    Unit cur, nxt; int ui = 0;
    if (!S.next(0, cur)) return;
    f32x4 acc[2][2][4][2];
#pragma unroll
    for (int a = 0; a < 2; ++a)
#pragma unroll
        for (int b = 0; b < 2; ++b)
#pragma unroll
            for (int m = 0; m < 4; ++m)
#pragma unroll
                for (int n = 0; n < 2; ++n) acc[a][b][m][n] = (f32x4){0.f, 0.f, 0.f, 0.f};
    bf16x8 At[4][2], B0[2][2], B1[2][2];
    const char* cA = (const char*)g.A + (size_t)cur.pm * tstep; const char* cB = (const char*)g.Bt + (size_t)cur.pn * tstep;
    S.a_ready(cur);
    if constexpr (SP2) {
        PG8_STAGE(PG8_SB(0, 0), cB, voffB); PG8_STAGE(PG8_SB(0, 1), cB + hstep, voffB); PG8_STAGE(PG8_SA(0, 0), cA, voffA); PG8_STAGE(PG8_SA(0, 1), cA + hstep, voffA);
        if (wr == 1) PG8_BAR;
        PG8_WAIT_V(2); PG8_BAR;
        PG8_STAGE(PG8_SB(1, 0), cB + kstep, voffB); PG8_STAGE(PG8_SA(1, 0), cA + kstep, voffA); PG8_STAGE(PG8_SB(1, 1), cB + hstep + kstep, voffB);
        PG8_WAIT_V(6); PG8_BAR;
    } else {
        PG8_STAGE(PG8_SB(0, 0), cB, voffB); PG8_STAGE(PG8_SA(0, 0), cA, voffA); PG8_STAGE(PG8_SB(0, 1), cB + hstep, voffB); PG8_STAGE(PG8_SA(0, 1), cA + hstep, voffA);
        if (wr == 1) PG8_BAR;
        PG8_WAIT_V(4); PG8_BAR;
        PG8_STAGE(PG8_SB(1, 0), cB + kstep, voffB); PG8_STAGE(PG8_SA(1, 0), cA + kstep, voffA); PG8_STAGE(PG8_SB(1, 1), cB + hstep + kstep, voffB);
        PG8_WAIT_V(6); PG8_BAR;
    }
    for (;;) {
        const bool has_next = S.next(ui + 1, nxt);
        const char* nA = has_next ? (const char*)g.A + (size_t)nxt.pm * tstep : cA; const char* nB = has_next ? (const char*)g.Bt + (size_t)nxt.pn * tstep : cB;
        for (int t = 0; t < nt; t += 2) {
            const bool last = (t == nt - 2);
            const char* a1 = cA + (size_t)(t + 1) * kstep;
            const char* a2 = last ? nA : cA + (size_t)(t + 2) * kstep; const char* b2 = last ? nB : cB + (size_t)(t + 2) * kstep;
            const char* a3 = a2 + kstep; const char* b3 = b2 + kstep;
            if (last && has_next) S.a_ready(nxt);
            if constexpr (SP2) {
            PG8_LDB(B0, 0, 0); PG8_LDB(B1, 0, 1); PG8_SCHED; PG8_LDA(At, 0, 0); PG8_STAGE(PG8_SA(1, 1), a1 + hstep, voffA);
            PG8_WAIT_V(8); PG8_WAIT_L(0); PG8_BAR; PG8_MMA(0, 0, At, B0); PG8_MMA(0, 1, At, B1); PG8_BAR; PG8_SCHED;
            PG8_LDA(At, 0, 1); PG8_STAGE(PG8_SB(0, 0), b2, voffB); PG8_STAGE(PG8_SB(0, 1), b2 + hstep, voffB); PG8_STAGE(PG8_SA(0, 0), a2, voffA);
            PG8_WAIT_V(8); PG8_WAIT_L(0); PG8_BAR; PG8_MMA(1, 0, At, B0); PG8_MMA(1, 1, At, B1); PG8_BAR; PG8_SCHED;
            PG8_LDB(B0, 1, 0); PG8_LDB(B1, 1, 1); PG8_SCHED; PG8_LDA(At, 1, 0); PG8_STAGE(PG8_SA(0, 1), a2 + hstep, voffA);
            PG8_WAIT_V(8); PG8_WAIT_L(0); PG8_BAR; PG8_MMA(0, 0, At, B0); PG8_MMA(0, 1, At, B1); PG8_BAR; PG8_SCHED;
            PG8_LDA(At, 1, 1); PG8_STAGE(PG8_SB(1, 0), b3, voffB); PG8_STAGE(PG8_SB(1, 1), b3 + hstep, voffB); PG8_STAGE(PG8_SA(1, 0), a3, voffA);
            PG8_WAIT_V(8); PG8_WAIT_L(0); PG8_BAR; PG8_MMA(1, 0, At, B0); PG8_MMA(1, 1, At, B1); PG8_BAR; PG8_SCHED;
            } else {
            PG8_LDB(B0, 0, 0); PG8_SCHED; PG8_LDA(At, 0, 0); PG8_STAGE(PG8_SA(1, 1), a1 + hstep, voffA);
            PG8_WAIT_L(8); PG8_BAR; PG8_WAIT_L(0); PG8_MMA(0, 0, At, B0); PG8_BAR; PG8_SCHED;
            PG8_LDB(B1, 0, 1); PG8_STAGE(PG8_SB(0, 0), b2, voffB);
            PG8_BAR; PG8_WAIT_L(0); PG8_MMA(0, 1, At, B1); PG8_BAR;
            PG8_LDA(At, 0, 1); PG8_STAGE(PG8_SA(0, 0), a2, voffA);
            PG8_BAR; PG8_WAIT_L(0); PG8_MMA(1, 0, At, B0); PG8_BAR; PG8_SCHED;
            PG8_STAGE(PG8_SB(0, 1), b2 + hstep, voffB);
            PG8_WAIT_V(6); PG8_BAR; PG8_MMA(1, 1, At, B1); PG8_BAR;
            PG8_LDB(B0, 1, 0); PG8_SCHED; PG8_LDA(At, 1, 0); PG8_STAGE(PG8_SA(0, 1), a2 + hstep, voffA);
            PG8_WAIT_L(8); PG8_BAR; PG8_WAIT_L(0); PG8_MMA(0, 0, At, B0); PG8_BAR; PG8_SCHED;
            PG8_LDB(B1, 1, 1); PG8_STAGE(PG8_SB(1, 0), b3, voffB);
            PG8_BAR; PG8_WAIT_L(0); PG8_MMA(0, 1, At, B1); PG8_BAR;
            PG8_LDA(At, 1, 1); PG8_STAGE(PG8_SA(1, 0), a3, voffA);
            PG8_BAR; PG8_WAIT_L(0); PG8_MMA(1, 0, At, B0); PG8_BAR; PG8_SCHED;
            PG8_STAGE(PG8_SB(1, 1), b3 + hstep, voffB);
            PG8_WAIT_V(6); PG8_BAR; PG8_MMA(1, 1, At, B1); PG8_BAR;
            }
        }
        if constexpr (ALIGN_EPI) { if (wr == 0) PG8_BAR; }
        if constexpr (!Epi::AFTER_DRAIN) { E(acc, cur, wr, wc, fr, fq); S.done(cur); }
        if (!has_next) break;
#pragma unroll
        for (int a = 0; a < 2; ++a)
#pragma unroll
            for (int b = 0; b < 2; ++b)
#pragma unroll
                for (int m = 0; m < 4; ++m)
#pragma unroll
                    for (int n = 0; n < 2; ++n) acc[a][b][m][n] = (f32x4){0.f, 0.f, 0.f, 0.f};
        cur = nxt; cA = nA; cB = nB; ++ui;
        if constexpr (ALIGN_EPI) { if (wr == 1) PG8_BAR; }
    }
    PG8_WAIT_V(0);
    if constexpr (!ALIGN_EPI) { if (wr == 0) PG8_BAR; }
    PG8_BAR;
    if constexpr (Epi::AFTER_DRAIN) { E.fused(acc, cur, wr, wc, fr, fq, lds, wid, lane); S.done(cur); }
#undef PG8_SA
#undef PG8_SB
#undef PG8_STAGE
#undef PG8_LDA
#undef PG8_LDB
#undef PG8_MMA
#undef PG8_WAIT_V
#undef PG8_WAIT_L
#undef PG8_BAR
#undef PG8_SCHED
}
}

namespace cg = cooperative_groups;
#define LAS __attribute__((address_space(3)))
typedef unsigned short bf16;
typedef float f32x4 __attribute__((ext_vector_type(4)));
typedef float f32x2 __attribute__((ext_vector_type(2)));
typedef short bf16x8 __attribute__((ext_vector_type(8)));
typedef short s16x4 __attribute__((ext_vector_type(4)));
typedef unsigned u32x4 __attribute__((ext_vector_type(4)));
typedef unsigned u32x2 __attribute__((ext_vector_type(2)));
#define LDS_WAIT() asm volatile("s_waitcnt lgkmcnt(0)" ::: "memory")

constexpr int NT = 98304, NTP = 65536, DM = 1024, ZW = 3200, ZWP = 3328, FFD = 4096, NTH = NT / 2;
constexpr size_t MiB = 1u << 20;
constexpr size_t WS_CTLB = 2 * MiB;
constexpr size_t CNT_OFF = 2 * MiB - 4096;
constexpr size_t WS_WIN = 2 * MiB, WS_WOUT = 15 * MiB, WS_W1 = 19 * MiB, WS_W2 = 35 * MiB, WS_HB = 52 * MiB, WS_ZB = 244 * MiB, WS_HID = 244 * MiB,
                 WS_RAW = 628 * MiB, WS_YB = 844 * MiB, WS_END = 988 * MiB;
constexpr int LDS_BYTES = 147456;
constexpr int N_SCAN_UNITS = 192, N_ATTN_UNITS = 2304;

struct Args { const float* in[25]; float* out; unsigned char* ws; };
typedef const __attribute__((address_space(4))) Args CArgs;
#define KARGS() ({ CArgs* p_ = (CArgs*)__builtin_amdgcn_kernarg_segment_ptr(); asm volatile("" : "+s"(p_)); p_; })

__device__ __forceinline__ float bf2f(unsigned short u) { return __uint_as_float((unsigned)u << 16); }
__device__ __forceinline__ unsigned f2bf(float f) { unsigned u = __float_as_uint(f); return (u + 0x7fffu + ((u >> 16) & 1u)) >> 16; }
__device__ __forceinline__ unsigned pk2(float lo, float hi) { return f2bf(lo) | (f2bf(hi) << 16); }
__device__ __forceinline__ float wave_sum(float v) {
#pragma unroll
    for (int o = 1; o < 64; o <<= 1) v += __shfl_xor(v, o);
    return v;
}
__device__ __forceinline__ float sigm(float x) { return 1.f / (1.f + __expf(-x)); }
__device__ __forceinline__ float tanh_(float x) { const float e = __expf(2.f * x); return 1.f - 2.f / (e + 1.f); }
#define DPP_F(v, ctrl) __int_as_float(__builtin_amdgcn_update_dpp(0, __float_as_int(v), (ctrl), 0xF, 0xF, true))
__device__ __forceinline__ float red8(float v) { v += DPP_F(v, 0xB1); v += DPP_F(v, 0x4E); v += DPP_F(v, 0x141); return v; }
__device__ __forceinline__ void seq_of(int m, int& T, int& seqbase, int& t) {
    if (m < NTP) { T = 4096; t = m & 4095; } else { T = 2048; t = (m - NTP) & 2047; }
    seqbase = m - t;
}

__device__ __forceinline__ void transpose_item(const float* W, int K, int N, bf16* WT, LAS float* scr, int item, int lane) {
    const int nblk = N / 32, kb = item / nblk, nb = item % nblk, k0 = 64 * kb, n0 = 32 * nb;
#pragma unroll 8
    for (int i = 0; i < 32; ++i) { const int kk = 2 * i + (lane >> 5); scr[kk * 33 + (lane & 31)] = W[(size_t)(k0 + kk) * N + n0 + (lane & 31)]; }
    LDS_WAIT();
    const int c = lane & 7;
#pragma unroll
    for (int j = 0; j < 4; ++j) { const int n = (lane >> 3) + 8 * j; const LAS float* s = scr + (8 * c) * 33 + n;
        u32x4 o; o.x = pk2(s[0 * 33], s[1 * 33]); o.y = pk2(s[2 * 33], s[3 * 33]); o.z = pk2(s[4 * 33], s[5 * 33]); o.w = pk2(s[6 * 33], s[7 * 33]);
        *(u32x4*)(WT + (size_t)(n0 + n) * K + k0 + 8 * c) = o; }
    LDS_WAIT();
}
__device__ __forceinline__ void phase_prologue(LAS unsigned char* lds, CArgs* ap, int gw, int NGW, int lane, int wave) {
    LAS float* scr = (LAS float*)(lds + wave * 16384);
    bf16* WIN = (bf16*)(ap->ws + WS_WIN); bf16* WOUT = (bf16*)(ap->ws + WS_WOUT); bf16* W1 = (bf16*)(ap->ws + WS_W1); bf16* W2 = (bf16*)(ap->ws + WS_W2);
    constexpr int I_IN = 16 * 100, I_OUT = 16 * 32, I_1 = 16 * 128, I_2 = 64 * 32, I_L = I_IN + I_OUT + I_1 + I_2;
    for (int it = gw; it < 2 * I_L; it += NGW) {
        const int l = it / I_L; int r = it % I_L;
        if (r < I_IN) { transpose_item(ap->in[7] + (size_t)l * DM * ZW, DM, ZW, WIN + (size_t)l * ZWP * DM, scr, r, lane); continue; } r -= I_IN;
        if (r < I_OUT) { transpose_item(ap->in[8] + (size_t)l * DM * DM, DM, DM, WOUT + (size_t)l * DM * DM, scr, r, lane); continue; } r -= I_OUT;
        if (r < I_1) { transpose_item(ap->in[23] + (size_t)l * DM * FFD, DM, FFD, W1 + (size_t)l * FFD * DM, scr, r, lane); continue; } r -= I_1;
        transpose_item(ap->in[24] + (size_t)l * FFD * DM, FFD, DM, W2 + (size_t)l * DM * FFD, scr, r, lane);
    }
    for (int i = gw * 64 + lane; i < 2 * 16384; i += NGW * 64) { const int l = i >> 14, o = i & 16383;
        *(u32x4*)(WIN + (size_t)l * ZWP * DM + (size_t)ZW * DM + (size_t)o * 8) = (u32x4){0u, 0u, 0u, 0u}; }
}

__device__ __forceinline__ void phase_norm0(const float* xp, const float* xs, const float* g, bf16* HB, int gw, int NGW, int lane) {
    for (int m = gw; m < NT; m += NGW) {
        const float* xr = (m < NTP) ? xp + (size_t)m * DM : xs + (size_t)(m - NTP) * DM;
        f32x4 v[4]; float ss = 0.f;
#pragma unroll
        for (int j = 0; j < 4; ++j) { v[j] = *(const f32x4*)(xr + 4 * lane + 256 * j); ss += (v[j].x * v[j].x + v[j].y * v[j].y) + (v[j].z * v[j].z + v[j].w * v[j].w); }
        ss = wave_sum(ss); const float rs = rsqrtf(ss * (1.f / DM) + 1e-6f);
#pragma unroll
        for (int j = 0; j < 4; ++j) { const f32x4 gg = *(const f32x4*)(g + 4 * lane + 256 * j);
            u32x2 o; o.x = pk2(v[j].x * rs * gg.x, v[j].y * rs * gg.y); o.y = pk2(v[j].z * rs * gg.z, v[j].w * rs * gg.w);
            *(u32x2*)(HB + (size_t)m * DM + 4 * lane + 256 * j) = o; }
    }
}
__device__ __forceinline__ void phase_resid(const float* xp, const float* xs, bool from_in, float* out, const bf16* RAW, const float* gpost, const float* gnext, bf16* HB,
                                            int gw, int NGW, int lane) {
    for (int m = gw; m < NT; m += NGW) {
        const float* xr = from_in ? ((m < NTP) ? xp + (size_t)m * DM : xs + (size_t)(m - NTP) * DM) : out + (size_t)m * DM;
        f32x4 r[4]; float sr = 0.f;
#pragma unroll
        for (int j = 0; j < 4; ++j) { const u32x2 rw = *(const u32x2*)(RAW + (size_t)m * DM + 4 * lane + 256 * j);
            r[j].x = __uint_as_float(rw.x << 16); r[j].y = __uint_as_float(rw.x & 0xffff0000u); r[j].z = __uint_as_float(rw.y << 16); r[j].w = __uint_as_float(rw.y & 0xffff0000u);
            sr += (r[j].x * r[j].x + r[j].y * r[j].y) + (r[j].z * r[j].z + r[j].w * r[j].w); }
        sr = wave_sum(sr); const float rs = rsqrtf(sr * (1.f / DM) + 1e-6f);
        f32x4 v[4]; float ss = 0.f;
#pragma unroll
        for (int j = 0; j < 4; ++j) {
            const f32x4 x = *(const f32x4*)(xr + 4 * lane + 256 * j); const f32x4 gp = *(const f32x4*)(gpost + 4 * lane + 256 * j);
            v[j] = x + r[j] * rs * gp;
            ss += (v[j].x * v[j].x + v[j].y * v[j].y) + (v[j].z * v[j].z + v[j].w * v[j].w);
            *(f32x4*)(out + (size_t)m * DM + 4 * lane + 256 * j) = v[j];
        }
        if (gnext) {
            ss = wave_sum(ss); const float rs2 = rsqrtf(ss * (1.f / DM) + 1e-6f);
#pragma unroll
            for (int j = 0; j < 4; ++j) { const f32x4 gg = *(const f32x4*)(gnext + 4 * lane + 256 * j);
                u32x2 o; o.x = pk2(v[j].x * rs2 * gg.x, v[j].y * rs2 * gg.y); o.y = pk2(v[j].z * rs2 * gg.z, v[j].w * rs2 * gg.w);
                *(u32x2*)(HB + (size_t)m * DM + 4 * lane + 256 * j) = o; }
        }
    }
}

#define SC_TOK(p, c) (((p) >> 4) ? (T - 1 - (16 * (c) + ((p) & 15))) : (16 * (c) + ((p) & 15)))
__device__ __forceinline__ void scan_unit(LAS unsigned char* lds, const bf16* ZB, float* YB, CArgs* ap, int l, int su, int tid, int lane, int wave) {
    const int seq = su / 6, h = su % 6;
    int T, seqbase; if (seq < 16) { T = 4096; seqbase = seq * 4096; } else { T = 2048; seqbase = NTP + (seq - 16) * 2048; }
    LAS float* WUP = (LAS float*)lds; LAS float* AUP = WUP + 4096; LAS float* VEC = AUP + 4096; LAS float* TW = VEC + 32 * 384; LAS float* TA = TW + 1024; LAS float* YL = TA + 1024;
    { const float* dup = ap->in[14] + (size_t)l * 2 * 32 * 384; const float* iup = ap->in[16] + (size_t)l * 2 * 32 * 384;
      for (int i = tid; i < 4096; i += 512) { const int dir = i >> 11, r = (i >> 6) & 31, j = i & 63; WUP[i] = dup[(dir * 32 + r) * 384 + h * 64 + j]; AUP[i] = iup[(dir * 32 + r) * 384 + h * 64 + j]; } }
    const int hc = h * 64 + lane;
    const float* mu = ap->in[12] + l * 1280;
    const float mu_r = mu[hc], mu_k = mu[384 + hc], mu_v = mu[768 + hc];
    const float w0f = ap->in[13][(l * 2 + 0) * 384 + hc], w0b = ap->in[13][(l * 2 + 1) * 384 + hc];
    const float a0f = ap->in[15][(l * 2 + 0) * 384 + hc], a0b = ap->in[15][(l * 2 + 1) * 384 + hc];
    const float kkc = ap->in[18][l * 384 + hc], kac = ap->in[19][l * 384 + hc];
    const int p1 = tid >> 4, q1 = tid & 15;
    const float mu1_0 = mu[1152 + q1], mu1_1 = mu[1168 + q1], mu1_2 = mu[1184 + q1], mu1_3 = mu[1200 + q1];
    const bf16* zrow0 = ZB + (size_t)seqbase * ZW;
    const int dir = wave >> 2, q4 = wave & 3, ri = lane >> 3, cj = lane & 7, i0 = 16 * q4 + 2 * ri;
    const int nch = T / 16;
    unsigned short z1[3][4], z2[4][3][3];
#define SC_LOAD(c) do { \
        { const int t_ = SC_TOK(p1, (c)); const bf16* zr_ = zrow0 + (size_t)t_ * ZW + 3072 + q1; const bool hp_ = t_ > 0, hn_ = t_ < T - 1; \
          _Pragma("unroll") for (int cc = 0; cc < 4; ++cc) { z1[1][cc] = zr_[16 * cc]; z1[0][cc] = hp_ ? zr_[16 * cc - ZW] : (unsigned short)0; z1[2][cc] = hn_ ? zr_[16 * cc + ZW] : (unsigned short)0; } } \
        _Pragma("unroll") for (int i = 0; i < 4; ++i) { const int p_ = wave + 8 * i; const int t_ = SC_TOK(p_, (c)); const bf16* zr_ = zrow0 + (size_t)t_ * ZW + 1920 + hc; const bool hp_ = t_ > 0, hn_ = t_ < T - 1; \
          _Pragma("unroll") for (int q = 0; q < 3; ++q) { z2[i][1][q] = zr_[384 * q]; z2[i][0][q] = hp_ ? zr_[384 * q - ZW] : (unsigned short)0; z2[i][2][q] = hn_ ? zr_[384 * q + ZW] : (unsigned short)0; } } \
    } while (0)
    f32x2 S0[4], S1[4];
#pragma unroll
    for (int q = 0; q < 4; ++q) { S0[q] = (f32x2){0.f, 0.f}; S1[q] = (f32x2){0.f, 0.f}; }
    SC_LOAD(0);
    __syncthreads();
    for (int c = 0; c < nch; ++c) {
        {
            float xs[4]; const float mus[4] = {mu1_0, mu1_1, mu1_2, mu1_3};
#pragma unroll
            for (int cc = 0; cc < 4; ++cc) { const float zc = bf2f(z1[1][cc]), zp = bf2f(z1[0][cc]), zn = bf2f(z1[2][cc]); xs[cc] = zc + (0.5f * (zp + zn) - zc) * mus[cc]; }
            TW[p1 * 32 + q1] = tanh_(xs[0]); TW[p1 * 32 + 16 + q1] = tanh_(xs[1]); TA[p1 * 32 + q1] = xs[2]; TA[p1 * 32 + 16 + q1] = xs[3];
        }
        __syncthreads();
#pragma unroll
        for (int i = 0; i < 4; ++i) {
            const int p = wave + 8 * i; const int d2 = i >> 1;
            const float rr = bf2f(z2[i][1][0]) + (0.5f * (bf2f(z2[i][0][0]) + bf2f(z2[i][2][0])) - bf2f(z2[i][1][0])) * mu_r;
            const float kk0 = bf2f(z2[i][1][1]) + (0.5f * (bf2f(z2[i][0][1]) + bf2f(z2[i][2][1])) - bf2f(z2[i][1][1])) * mu_k;
            const float vv = bf2f(z2[i][1][2]) + (0.5f * (bf2f(z2[i][0][2]) + bf2f(z2[i][2][2])) - bf2f(z2[i][1][2])) * mu_v;
            float wsum = d2 ? w0b : w0f, asum = d2 ? a0b : a0f;
            const LAS float* twp = TW + p * 32; const LAS float* tap = TA + p * 32; const LAS float* wup = WUP + d2 * 2048 + lane; const LAS float* aup = AUP + d2 * 2048 + lane;
#pragma unroll 2
            for (int r4 = 0; r4 < 8; ++r4) { const f32x4 tw = *(const LAS f32x4*)(twp + 4 * r4), ta = *(const LAS f32x4*)(tap + 4 * r4);
#pragma unroll
                for (int e = 0; e < 4; ++e) { wsum += tw[e] * wup[(4 * r4 + e) * 64]; asum += ta[e] * aup[(4 * r4 + e) * 64]; } }
            const float decay = __expf(-0.6065306597f * sigm(wsum));
            const float av = sigm(asum);
            float kk = kk0 * kkc; const float n2 = wave_sum(kk * kk); kk = kk / fmaxf(sqrtf(n2), 1e-12f);
            const float kd = kk0 * (1.f + (av - 1.f) * kac);
            LAS float* vp = VEC + p * 384 + lane; vp[0] = decay; vp[64] = kd; vp[128] = kk * av; vp[192] = -kk; vp[256] = rr; vp[320] = vv;
            __builtin_amdgcn_sched_barrier(0);
        }
        __syncthreads();
        if (c + 1 < nch) SC_LOAD(c + 1);
#pragma unroll 2
        for (int s = 0; s < 16; ++s) {
            const int p = dir * 16 + s; const LAS float* vp = VEC + p * 384 + 8 * cj;
            const f32x4 ama = *(const LAS f32x4*)(vp + 192), amb = *(const LAS f32x4*)(vp + 196);
            const f32x2 am[4] = {(f32x2){ama.x, ama.y}, (f32x2){ama.z, ama.w}, (f32x2){amb.x, amb.y}, (f32x2){amb.z, amb.w}};
            f32x2 t0 = S0[0] * am[0], t1 = S1[0] * am[0];
#pragma unroll
            for (int q = 1; q < 4; ++q) { t0 += S0[q] * am[q]; t1 += S1[q] * am[q]; }
            const float sa0 = red8(t0.x + t0.y), sa1 = red8(t1.x + t1.y);
            const f32x4 wa = *(const LAS f32x4*)(vp), wb = *(const LAS f32x4*)(vp + 4), ka = *(const LAS f32x4*)(vp + 64), kb = *(const LAS f32x4*)(vp + 68);
            const f32x4 ba = *(const LAS f32x4*)(vp + 128), bb = *(const LAS f32x4*)(vp + 132), ra = *(const LAS f32x4*)(vp + 256), rb = *(const LAS f32x4*)(vp + 260);
            const f32x2 vv = *(const LAS f32x2*)(VEC + p * 384 + 320 + i0);
            const f32x2 w2[4] = {(f32x2){wa.x, wa.y}, (f32x2){wa.z, wa.w}, (f32x2){wb.x, wb.y}, (f32x2){wb.z, wb.w}};
            const f32x2 k2[4] = {(f32x2){ka.x, ka.y}, (f32x2){ka.z, ka.w}, (f32x2){kb.x, kb.y}, (f32x2){kb.z, kb.w}};
            const f32x2 b2[4] = {(f32x2){ba.x, ba.y}, (f32x2){ba.z, ba.w}, (f32x2){bb.x, bb.y}, (f32x2){bb.z, bb.w}};
            const f32x2 r2[4] = {(f32x2){ra.x, ra.y}, (f32x2){ra.z, ra.w}, (f32x2){rb.x, rb.y}, (f32x2){rb.z, rb.w}};
            f32x2 y0 = (f32x2){0.f, 0.f}, y1 = (f32x2){0.f, 0.f};
#pragma unroll
            for (int q = 0; q < 4; ++q) {
                S0[q] = S0[q] * w2[q] + b2[q] * sa0 + k2[q] * vv.x; y0 += S0[q] * r2[q];
                S1[q] = S1[q] * w2[q] + b2[q] * sa1 + k2[q] * vv.y; y1 += S1[q] * r2[q];
            }
            const float yy0 = red8(y0.x + y0.y), yy1 = red8(y1.x + y1.y);
            if (cj == 0) *(LAS f32x2*)(YL + p * 64 + i0) = (f32x2){yy0, yy1};
        }
        __syncthreads();
        {
            const int t = SC_TOK(p1, c); float* dst = YB + (size_t)(seqbase + t) * 384 + h * 64 + 4 * q1; const f32x4 val = *(const LAS f32x4*)(YL + p1 * 64 + 4 * q1);
            if (c < nch / 2) *(f32x4*)dst = val;
            else { unsafeAtomicAdd(dst + 0, val.x); unsafeAtomicAdd(dst + 1, val.y); unsafeAtomicAdd(dst + 2, val.z); unsafeAtomicAdd(dst + 3, val.w); }
        }
    }
#undef SC_LOAD
}

constexpr int AT_OACC = 0, AT_M = 256 * 68 * 4, AT_L = AT_M + 1024, AT_VT = AT_L + 1024, AT_VT_W = 64 * 36 * 2, AT_BT = AT_VT + 8 * AT_VT_W, AT_END = AT_BT + 18 * 132 * 4;
static_assert(AT_END <= LDS_BYTES - 64 && AT_BT >= 98304, "attention LDS map (the bias table must sit above the scan's LDS)");
__device__ __forceinline__ void attn_unit(LAS unsigned char* lds, const bf16* ZB, bf16* HB, int u, int tid, int lane, int wave) {
    LAS float* OACC = (LAS float*)(lds + AT_OACC); LAS float* MACC = (LAS float*)(lds + AT_M); LAS float* LACC = (LAS float*)(lds + AT_L);
    LAS unsigned* VTw = (LAS unsigned*)(lds + AT_VT + wave * AT_VT_W); LAS unsigned short* VTh = (LAS unsigned short*)VTw; const LAS float* BT = (const LAS float*)(lds + AT_BT);
    const int h = u % 6, rg = u / 6, mg = rg * 256;
    int T, seqbase, t0; seq_of(mg, T, seqbase, t0);
    const bf16* zseq = ZB + (size_t)seqbase * ZW;
    const int qi = lane & 15, kg = lane >> 4;
    for (int br = 0; br < 3; ++br) {
        const int sh = 2 * br, L = T >> sh;
        const LAS float* bt = BT + (br * 6 + h) * 132;
        for (int jj = 0; jj < 2; ++jj) {
            const int j = wave * 2 + jj;
            int c, m0;
            if (br == 0) { c = 0; m0 = t0 + 16 * j; } else if (br == 1) { c = j & 3; m0 = (t0 >> 2) + 16 * (j >> 2); } else { c = j; m0 = t0 >> 4; }
            const int tq = ((m0 + qi) << sh) + c;
            const bf16* qp = zseq + (size_t)tq * ZW + h * 64 + 8 * kg;
            const bf16x8 Q0 = *(const bf16x8*)qp, Q1 = *(const bf16x8*)(qp + 32);
            float lg[10][4];
            float mx = -1e30f;
#pragma unroll
            for (int jt = 0; jt < 10; ++jt) {
                const int kw = m0 - 64 + 16 * jt + qi; const bool kv = (kw >= 0) && (kw < L);
                const int tk = kv ? ((kw << sh) + c) : 0;
                const bf16* kp = zseq + (size_t)tk * ZW + 384 + h * 64 + 8 * kg;
                bf16x8 K0 = *(const bf16x8*)kp, K1 = *(const bf16x8*)(kp + 32);
                if (!kv) { K0 = (bf16x8){0, 0, 0, 0, 0, 0, 0, 0}; K1 = K0; }
                f32x4 s = (f32x4){0.f, 0.f, 0.f, 0.f};
                s = __builtin_amdgcn_mfma_f32_16x16x32_bf16(K0, Q0, s, 0, 0, 0);
                s = __builtin_amdgcn_mfma_f32_16x16x32_bf16(K1, Q1, s, 0, 0, 0);
#pragma unroll
                for (int e = 0; e < 4; ++e) {
                    const int jk = 16 * jt + 4 * kg + e, rel = jk - 64 - qi, kw2 = m0 - 64 + jk;
                    const bool ok = (rel >= -64) && (rel <= 64) && (kw2 >= 0) && (kw2 < L);
                    const int bi = min(max(rel + 64, 0), 128);
                    const float v = ok ? (s[e] * 0.125f + bt[bi]) : -1e30f;
                    lg[jt][e] = v; mx = fmaxf(mx, v);
                }
                __builtin_amdgcn_sched_barrier(0);
            }
            mx = fmaxf(mx, __shfl_xor(mx, 16)); mx = fmaxf(mx, __shfl_xor(mx, 32));
            float lsum = 0.f;
#pragma unroll
            for (int jt = 0; jt < 10; ++jt)
#pragma unroll
                for (int e = 0; e < 4; ++e) { const float p = __expf(lg[jt][e] - mx); lg[jt][e] = p; lsum += p; }
            lsum += __shfl_xor(lsum, 16); lsum += __shfl_xor(lsum, 32);
            f32x4 Oa[4];
#pragma unroll
            for (int dt = 0; dt < 4; ++dt) Oa[dt] = (f32x4){0.f, 0.f, 0.f, 0.f};
#pragma unroll
            for (int kt = 0; kt < 5; ++kt) {
#pragma unroll
                for (int u2 = 0; u2 < 2; ++u2) {
                    const int pid = lane + 64 * u2, rp = pid & 15, dc = pid >> 4;
                    const int kwa = m0 - 64 + 32 * kt + 2 * rp, kwb = kwa + 1;
                    const bool va = (kwa >= 0) && (kwa < L), vb = (kwb >= 0) && (kwb < L);
                    const int ta = va ? ((kwa << sh) + c) : 0, tb = vb ? ((kwb << sh) + c) : 0;
                    u32x4 xa = *(const u32x4*)(zseq + (size_t)ta * ZW + 768 + h * 64 + 8 * dc), xb = *(const u32x4*)(zseq + (size_t)tb * ZW + 768 + h * 64 + 8 * dc);
                    if (!va) xa = (u32x4){0u, 0u, 0u, 0u};
                    if (!vb) xb = (u32x4){0u, 0u, 0u, 0u};
                    LAS unsigned* wp = VTw + (8 * dc) * 18 + rp;
                    wp[0 * 18] = (xa.x & 0xffffu) | (xb.x << 16); wp[1 * 18] = (xa.x >> 16) | (xb.x & 0xffff0000u);
                    wp[2 * 18] = (xa.y & 0xffffu) | (xb.y << 16); wp[3 * 18] = (xa.y >> 16) | (xb.y & 0xffff0000u);
                    wp[4 * 18] = (xa.z & 0xffffu) | (xb.z << 16); wp[5 * 18] = (xa.z >> 16) | (xb.z & 0xffff0000u);
                    wp[6 * 18] = (xa.w & 0xffffu) | (xb.w << 16); wp[7 * 18] = (xa.w >> 16) | (xb.w & 0xffff0000u);
                }
                LDS_WAIT();
                u32x4 pw; pw.x = pk2(lg[2 * kt][0], lg[2 * kt][1]); pw.y = pk2(lg[2 * kt][2], lg[2 * kt][3]); pw.z = pk2(lg[2 * kt + 1][0], lg[2 * kt + 1][1]); pw.w = pk2(lg[2 * kt + 1][2], lg[2 * kt + 1][3]);
                const bf16x8 Pf = __builtin_bit_cast(bf16x8, pw);
#pragma unroll
                for (int dt = 0; dt < 4; ++dt) {
                    const LAS unsigned short* rp_ = VTh + (16 * dt + qi) * 36 + 4 * kg;
                    const u32x2 lo = *(const LAS u32x2*)rp_, hi = *(const LAS u32x2*)(rp_ + 16);
                    u32x4 aw; aw.x = lo.x; aw.y = lo.y; aw.z = hi.x; aw.w = hi.y;
                    Oa[dt] = __builtin_amdgcn_mfma_f32_16x16x32_bf16(__builtin_bit_cast(bf16x8, aw), Pf, Oa[dt], 0, 0, 0);
                }
                LDS_WAIT();
                __builtin_amdgcn_sched_barrier(0);
            }
            const int tok = tq - t0; LAS float* op = OACC + tok * 68 + 4 * kg;
            if (br == 0) {
#pragma unroll
                for (int dt = 0; dt < 4; ++dt) *(LAS f32x4*)(op + 16 * dt) = Oa[dt];
                if (kg == 0) { MACC[tok] = mx; LACC[tok] = lsum; }
            } else {
                const float mo = MACC[tok], lo_ = LACC[tok]; const float mn = fmaxf(mo, mx); const float so = __expf(mo - mn), sc = __expf(mx - mn);
#pragma unroll
                for (int dt = 0; dt < 4; ++dt) { f32x4 o = *(LAS f32x4*)(op + 16 * dt); o = o * so + Oa[dt] * sc; *(LAS f32x4*)(op + 16 * dt) = o; }
                LDS_WAIT();
                if (kg == 0) { MACC[tok] = mn; LACC[tok] = lo_ * so + lsum * sc; }
            }
        }
        __syncthreads();
    }
    {
        const int tok = tid >> 1, half = tid & 1; const float inv = 1.f / LACC[tok]; const LAS float* op = OACC + tok * 68 + 32 * half;
        bf16* dst = HB + (size_t)(mg + tok) * DM + h * 64 + 32 * half;
#pragma unroll
        for (int q = 0; q < 4; ++q) { const f32x4 x0 = *(const LAS f32x4*)(op + 8 * q), x1 = *(const LAS f32x4*)(op + 8 * q + 4);
            u32x4 w; w.x = pk2(x0.x * inv, x0.y * inv); w.y = pk2(x0.z * inv, x0.w * inv); w.z = pk2(x1.x * inv, x1.y * inv); w.w = pk2(x1.z * inv, x1.w * inv);
            *(u32x4*)(dst + 8 * q) = w; }
    }
    __syncthreads();
}
__device__ __forceinline__ int t5_bucket_dev(int rd) {
    const int n = rd < 0 ? -rd : rd; const int ret = rd > 0 ? 16 : 0;
    const int v = n < 8 ? n : (n < 15 ? 8 : (n < 27 ? 9 : (n < 50 ? 10 : (n < 91 ? 11 : (n < 166 ? 12 : (n < 305 ? 13 : (n < 559 ? 14 : 15)))))));
    return ret + v;
}
__device__ __forceinline__ void phase_mixers(LAS unsigned char* lds, const bf16* ZB, float* YB, bf16* HB, CArgs* ap, int l, unsigned* counter, int tid, int lane, int wave) {
    {   LAS float* BT = (LAS float*)(lds + AT_BT); const float* rb = ap->in[2];
        for (int i = tid; i < 3 * 6 * 129; i += 512) { const int br = i / (6 * 129), rem = i % (6 * 129), h = rem / 129, ri = rem % 129; const int rel = ri - 64;
            BT[(br * 6 + h) * 132 + ri] = rb[t5_bucket_dev(rel << (2 * br)) * 6 + h]; } }
    __syncthreads();
#ifndef NO_SCAN
    for (int su = blockIdx.x; su < N_SCAN_UNITS; su += gridDim.x) { scan_unit(lds, ZB, YB, ap, l, su, tid, lane, wave); __syncthreads(); }
#endif
    LAS int* flag = (LAS int*)(lds + LDS_BYTES - 16);
    for (;;) {
        if (tid == 0) *flag = (int)atomicAdd(counter, 1u);
        __syncthreads();
        const int u = *flag;
        __syncthreads();
        if (u >= N_ATTN_UNITS) break;
#ifndef NO_ATTN
        attn_unit(lds, ZB, HB, u, tid, lane, wave);
#endif
    }
}

__device__ __forceinline__ void phase_final(LAS unsigned char* lds, const bf16* ZB, const float* YB, bf16* HB, CArgs* ap, int l, int gw, int NGW, int lane, int wave) {
    LAS float* SA = (LAS float*)(lds + wave * 2048); LAS float* SG = SA + 128;
    const float* mu = ap->in[12] + l * 1280; const float* ga = ap->in[9] + l * 384; const float* cw = ap->in[10] + l * 768; const float* cgn = ap->in[11] + l * 256;
    const float* a0 = ap->in[15] + l * 768; const float* aup = ap->in[16] + (size_t)l * 2 * 32 * 384; const float* gup = ap->in[17] + (size_t)l * 64 * 384;
    const float* k_a = ap->in[19] + l * 384; const float* r_k = ap->in[20] + l * 384; const float* lnw = ap->in[21] + l * 384; const float* lnb = ap->in[22] + l * 384;
    const float mu_ad = mu[1184 + (lane & 31)], mu_gd = mu[1216 + lane];
    for (int grp = gw; grp < NT / 4; grp += NGW) {
        const int m0 = grp * 4; int T, seqbase, t0; seq_of(m0, T, seqbase, t0);
#pragma unroll 1
        for (int tk = 0; tk < 4; ++tk) {
            const int m = m0 + tk, t = t0 + tk; const bf16* zr = ZB + (size_t)m * ZW; const bool hp = t > 0, hn = t < T - 1;
            {   bf16* hr = HB + (size_t)m * DM; float v[6]; float ss = 0.f;
#pragma unroll
                for (int e = 0; e < 6; ++e) { v[e] = bf2f(hr[lane + 64 * e]); ss += v[e] * v[e]; }
                ss = wave_sum(ss); const float rs = rsqrtf(ss * (1.f / 384.f) + 1e-6f);
#pragma unroll
                for (int e = 0; e < 6; ++e) hr[lane + 64 * e] = (bf16)f2bf(v[e] * rs * ga[lane + 64 * e]); }
            {   float y[4]; float ss = 0.f;
#pragma unroll
                for (int e = 0; e < 4; ++e) { const int c = lane + 64 * e; const float bg = bf2f(zr[1152 + c]); const float u1 = bf2f(zr[1408 + c]) * bf2f(zr[1664 + c]);
                    const float u0 = hp ? bf2f(zr[1408 + c - ZW]) * bf2f(zr[1664 + c - ZW]) : 0.f; const float u2 = hn ? bf2f(zr[1408 + c + ZW]) * bf2f(zr[1664 + c + ZW]) : 0.f;
                    y[e] = bg * (u0 * cw[c] + u1 * cw[256 + c] + u2 * cw[512 + c]); ss += y[e] * y[e]; }
                ss = wave_sum(ss); const float rs = rsqrtf(ss * (1.f / 256.f) + 1e-6f);
#pragma unroll
                for (int e = 0; e < 4; ++e) { const int c = lane + 64 * e; HB[(size_t)m * DM + 384 + c] = (bf16)f2bf(y[e] * rs * cgn[c]); } }
            {   const int ca = 3104 + (lane & 31); const float zc = bf2f(zr[ca]), zp = hp ? bf2f(zr[ca - ZW]) : 0.f, zn = hn ? bf2f(zr[ca + ZW]) : 0.f;
                if (lane < 32) SA[tk * 32 + lane] = zc + (0.5f * (zp + zn) - zc) * mu_ad;
                const int cgd = 3136 + lane; const float gc = bf2f(zr[cgd]), gp = hp ? bf2f(zr[cgd - ZW]) : 0.f, gn = hn ? bf2f(zr[cgd + ZW]) : 0.f;
                SG[tk * 64 + lane] = sigm(gc + (0.5f * (gp + gn) - gc) * mu_gd); }
        }
        LDS_WAIT();
#pragma unroll 1
        for (int h = 0; h < 6; ++h) {
            const int c = h * 64 + lane;
            float as0[4], as1[4], gs[4];
#pragma unroll
            for (int tk = 0; tk < 4; ++tk) { as0[tk] = a0[c]; as1[tk] = a0[384 + c]; gs[tk] = 0.f; }
#pragma unroll 1
            for (int r4 = 0; r4 < 8; ++r4) {
                float w0[4], w1[4];
#pragma unroll
                for (int e = 0; e < 4; ++e) { w0[e] = aup[(4 * r4 + e) * 384 + c]; w1[e] = aup[(32 + 4 * r4 + e) * 384 + c]; }
#pragma unroll
                for (int tk = 0; tk < 4; ++tk) { const f32x4 sa = *(const LAS f32x4*)(SA + tk * 32 + 4 * r4);
#pragma unroll
                    for (int e = 0; e < 4; ++e) { as0[tk] += sa[e] * w0[e]; as1[tk] += sa[e] * w1[e]; } }
            }
#pragma unroll 1
            for (int r4 = 0; r4 < 16; ++r4) {
                float wg[4];
#pragma unroll
                for (int e = 0; e < 4; ++e) wg[e] = gup[(4 * r4 + e) * 384 + c];
#pragma unroll
                for (int tk = 0; tk < 4; ++tk) { const f32x4 sg = *(const LAS f32x4*)(SG + tk * 64 + 4 * r4);
#pragma unroll
                    for (int e = 0; e < 4; ++e) gs[tk] += sg[e] * wg[e]; }
            }
            const float mur = mu[c], muk = mu[384 + c], muv = mu[768 + c], kac = k_a[c], rkc = r_k[c], lw = lnw[c], lb = lnb[c];
#pragma unroll
            for (int tk = 0; tk < 4; ++tk) {
                const int m = m0 + tk, t = t0 + tk; const bf16* zr = ZB + (size_t)m * ZW + 1920 + c; const bool hp = t > 0, hn = t < T - 1;
                float x3[3];
#pragma unroll
                for (int q = 0; q < 3; ++q) { const float zc = bf2f(zr[384 * q]), zp = hp ? bf2f(zr[384 * q - ZW]) : 0.f, zn = hn ? bf2f(zr[384 * q + ZW]) : 0.f;
                    x3[q] = zc + (0.5f * (zp + zn) - zc) * (q == 0 ? mur : (q == 1 ? muk : muv)); }
                const float av0 = sigm(as0[tk]), av1 = sigm(as1[tk]);
                const float kd0 = x3[1] * (1.f + (av0 - 1.f) * kac), kd1 = x3[1] * (1.f + (av1 - 1.f) * kac);
                const float bon = wave_sum(x3[0] * (kd0 + kd1) * rkc);
                const float y = YB[(size_t)m * 384 + c];
                const float mean = wave_sum(y) * (1.f / 64.f); const float dy = y - mean; const float var = wave_sum(dy * dy) * (1.f / 64.f);
                const float yn = dy * rsqrtf(var + 64e-5f) * lw + lb;
                HB[(size_t)m * DM + 640 + c] = (bf16)f2bf((yn + bon * x3[2]) * gs[tk]);
            }
        }
        LDS_WAIT();
    }
}

#define WSP(off) (ap->ws + (off))
__global__ void __launch_bounds__(512, 2) mega_fwd(Args a_unused) {
    extern __shared__ __attribute__((aligned(16))) unsigned char lds_raw[];
    LAS unsigned char* lds = (LAS unsigned char*)lds_raw;
    cg::grid_group grid = cg::this_grid();
#define IDS() int tid_l_ = threadIdx.x; asm volatile("" : "+v"(tid_l_)); const int tid = tid_l_, lane = tid & 63, wave = __builtin_amdgcn_readfirstlane(tid >> 6); const int G = gridDim.x, gw = blockIdx.x * 8 + wave, NGW = G * 8; (void)tid; (void)lane; (void)gw; (void)NGW; (void)G
#ifdef ONLY_MIX
    {   IDS(); CArgs* ap = KARGS(); const int l = 0;
        phase_mixers(lds, (const bf16*)WSP(WS_ZB), (float*)WSP(WS_YB), (bf16*)WSP(WS_HB), ap, l, (unsigned*)WSP(CNT_OFF) + 64 * l, tid, lane, wave); }
    return;
#endif
    {   IDS(); CArgs* ap = KARGS();
        phase_prologue(lds, ap, gw, NGW, lane, wave);
        phase_norm0(ap->in[0], ap->in[1], ap->in[3], (bf16*)WSP(WS_HB), gw, NGW, lane); }
    grid.sync();
#pragma unroll 1
    for (int l = 0; l < 2; ++l) {
        {   IDS(); CArgs* ap = KARGS();
            pg8::Gemm g{(bf16*)WSP(WS_HB), (bf16*)WSP(WS_WIN) + (size_t)l * ZWP * DM, NT, ZWP, DM}; pg8::StaticOrder S; S.init(NT, ZWP, G, (int)blockIdx.x);
            pg8::EpiMy<0> E{(bf16*)WSP(WS_ZB), ZW, ZW, nullptr};
            pg8::gemm_phase<pg8::EpiMy<0>, pg8::StaticOrder, true, true>(lds, g, S, E); }
        grid.sync();
        {   IDS(); CArgs* ap = KARGS();
#ifndef NO_MIX
            phase_mixers(lds, (const bf16*)WSP(WS_ZB), (float*)WSP(WS_YB), (bf16*)WSP(WS_HB), ap, l, (unsigned*)WSP(CNT_OFF) + 64 * l, tid, lane, wave);
#endif
        }
        grid.sync();
        {   IDS(); CArgs* ap = KARGS();
#ifndef NO_FINAL
            phase_final(lds, (const bf16*)WSP(WS_ZB), (const float*)WSP(WS_YB), (bf16*)WSP(WS_HB), ap, l, gw, NGW, lane, wave);
#endif
        }
        grid.sync();
        {   IDS(); CArgs* ap = KARGS();
            pg8::Gemm g{(bf16*)WSP(WS_HB), (bf16*)WSP(WS_WOUT) + (size_t)l * DM * DM, NT, DM, DM}; pg8::StaticOrder S; S.init(NT, DM, G, (int)blockIdx.x);
            pg8::EpiMy<0> E{(bf16*)WSP(WS_RAW), DM, DM, nullptr};
            pg8::gemm_phase<pg8::EpiMy<0>, pg8::StaticOrder, true, true>(lds, g, S, E); }
        grid.sync();
        {   IDS(); CArgs* ap = KARGS();
            phase_resid(ap->in[0], ap->in[1], l == 0, ap->out, (const bf16*)WSP(WS_RAW), ap->in[4] + l * DM, ap->in[5] + l * DM, (bf16*)WSP(WS_HB), gw, NGW, lane); }
        grid.sync();
#pragma unroll 1
        for (int hf = 0; hf < 2; ++hf) {
            {   IDS(); CArgs* ap = KARGS();
                pg8::Gemm g{(bf16*)WSP(WS_HB) + (size_t)hf * NTH * DM, (bf16*)WSP(WS_W1) + (size_t)l * FFD * DM, NTH, FFD, DM}; pg8::StaticOrder S; S.init(NTH, FFD, G, (int)blockIdx.x);
                pg8::EpiMy<1> E{(bf16*)WSP(WS_HID), FFD, FFD, nullptr};
                pg8::gemm_phase<pg8::EpiMy<1>, pg8::StaticOrder, true, true>(lds, g, S, E); }
            grid.sync();
            {   IDS(); CArgs* ap = KARGS();
                pg8::Gemm g{(bf16*)WSP(WS_HID), (bf16*)WSP(WS_W2) + (size_t)l * DM * FFD, NTH, DM, FFD}; pg8::StaticOrder S; S.init(NTH, DM, G, (int)blockIdx.x);
                pg8::EpiMy<0> E{(bf16*)WSP(WS_RAW) + (size_t)hf * NTH * DM, DM, DM, nullptr};
                pg8::gemm_phase<pg8::EpiMy<0>, pg8::StaticOrder, true, true>(lds, g, S, E); }
            grid.sync();
        }
        {   IDS(); CArgs* ap = KARGS();
            phase_resid(ap->in[0], ap->in[1], false, ap->out, (const bf16*)WSP(WS_RAW), ap->in[6] + l * DM, (l == 0) ? ap->in[3] + DM : nullptr, (bf16*)WSP(WS_HB), gw, NGW, lane); }
        if (l == 0) grid.sync();
    }
}

extern "C" void kernel_launch(void* const* d_in, const int* in_sizes, int n_in, void* d_out, int out_size, void* d_ws, size_t ws_size, hipStream_t stream) {
    static int grid = 0;
    if (grid == 0) {
        if (n_in != 25 || out_size != NT * DM || ws_size < WS_END) { fprintf(stderr, "kernel_launch: unexpected shapes (n_in %d, out %d, ws %zu)\n", n_in, out_size, ws_size); grid = -1; return; }
        int dev = 0, cus = 0, per_cu = 0;
        if (hipGetDevice(&dev) != hipSuccess || hipDeviceGetAttribute(&cus, hipDeviceAttributeMultiprocessorCount, dev) != hipSuccess) { grid = -1; return; }
        if (hipFuncSetAttribute((const void*)mega_fwd, hipFuncAttributeMaxDynamicSharedMemorySize, LDS_BYTES) != hipSuccess) { fprintf(stderr, "kernel_launch: hipFuncSetAttribute failed\n"); grid = -1; return; }
        if (hipOccupancyMaxActiveBlocksPerMultiprocessor(&per_cu, (const void*)mega_fwd, 512, LDS_BYTES) != hipSuccess || per_cu < 1) { fprintf(stderr, "kernel_launch: occupancy query says %d\n", per_cu); per_cu = 1; }
        (void)hipGetLastError();
        grid = cus;
    }
    if (grid < 0) return;
    (void)hipMemsetAsync(d_ws, 0, WS_CTLB, stream);
    Args a{};
    for (int i = 0; i < 25; ++i) a.in[i] = (const float*)d_in[i];
    a.out = (float*)d_out; a.ws = (unsigned char*)d_ws;
    void* args[] = {&a};
    const hipError_t e = hipLaunchCooperativeKernel((const void*)mega_fwd, dim3(grid), dim3(512), args, LDS_BYTES, stream);
    if (e != hipSuccess) fprintf(stderr, "kernel_launch: cooperative launch failed: %s (grid %d)\n", hipGetErrorString(e), grid);
}
```

```cpp
#include <hip/hip_runtime.h>
#include <hip/hip_cooperative_groups.h>
#include <cstdio>
#include <cstdint>
namespace pg8 {
#define PG8_LAS __attribute__((address_space(3)))
typedef unsigned short bf16_t;
typedef short bf16x8 __attribute__((ext_vector_type(8)));
typedef float f32x4 __attribute__((ext_vector_type(4)));
typedef unsigned u32x4 __attribute__((ext_vector_type(4)));
constexpr int BM = 256, BK = 64, HALF = 128, HTB = HALF * BK * 2  , STAGE_BYTES = 8 * HTB, NXCD = 8, WGM = 8;

__host__ __device__ __forceinline__ int lds_byte(int r, int c) { const int st = (r >> 4) * 2 + (c >> 5), rr = r & 15, cc = c & 31, ob = rr * 64 + cc * 2; return st * 1024 + (ob ^ (((ob >> 9) & 1) << 5)); }
__host__ __device__ __forceinline__ void stage_rc(int b, int& R, int& C) { const int st = b / 1024, sb = b % 1024, swz = sb ^ (((sb >> 9) & 1) << 5); R = (st >> 1) * 16 + swz / 64; C = (st & 1) * 32 + (swz % 64) / 2; }
__host__ __device__ __forceinline__ int perm32(int rho) { const int n = rho >> 4, i = rho & 15; return 8 * (i >> 2) + 4 * n + (i & 3); }

struct Unit { int pm, pn; };
struct Gemm { const bf16_t* A; const bf16_t* Bt; int M, N, K; };

struct StaticOrder {
    int nM, nN, nwg, G, c;
    __host__ __device__ void init(int M, int N, int G_, int c_) { nM = M / BM; nN = N / BM; nwg = nM * nN; G = G_; c = c_; }
    __host__ __device__ bool next(int i, Unit& u) const {
        const long L = (long)i * G + c; if (L >= nwg) return false;
        int wgid = (int)L; { const int q = nwg / NXCD, r = nwg % NXCD, xcd = wgid % NXCD, off = wgid / NXCD; wgid = (xcd < r ? xcd * (q + 1) : r * (q + 1) + (xcd - r) * q) + off; }
        const int nig = WGM * nN, gid = wgid / nig, fm = gid * WGM, gsz = (nM - fm) < WGM ? (nM - fm) : WGM;
        u.pm = fm + ((wgid % nig) % gsz); u.pn = (wgid % nig) / gsz; return true;
    }
    __device__ __forceinline__ void a_ready(const Unit&) const {}
    __device__ __forceinline__ void done(const Unit&) const {}
};

__device__ __forceinline__ unsigned cvt_pk_bf16(float lo, float hi) { unsigned r; asm volatile("v_cvt_pk_bf16_f32 %0, %1, %2" : "=v"(r) : "v"(lo), "v"(hi)); return r; }
typedef float f32x2 __attribute__((ext_vector_type(2)));
__device__ __forceinline__ f32x2 gelu_pk(f32x2 v) {
    const f32x2 av = __builtin_elementwise_abs(v), d = av * 0.2316418882f + 1.0f;
    f32x2 t; t.x = __builtin_amdgcn_rcpf(d.x); t.y = __builtin_amdgcn_rcpf(d.y);
    f32x2 q = t * 0.5307027145f + (-0.7265760135f); q = q * t + 0.7107068705f; q = q * t + (-0.142248368f); q = q * t + 0.127414796f; q = q * t;
    const f32x2 s = (v * v) * (-0.72134752044f);
    f32x2 e; e.x = __builtin_amdgcn_exp2f(s.x); e.y = __builtin_amdgcn_exp2f(s.y);
    const f32x2 m = v * (q * e), r = v - m;
    f32x2 o; o.x = v.x < 0.f ? m.x : r.x; o.y = v.y < 0.f ? m.y : r.y; return o;
}

template <int ACT  > struct EpiBf16 {
    static constexpr bool PERM = true, AFTER_DRAIN = false; static_assert(ACT == 0 || ACT == 1, "EpiBf16: ACT is 0 (none) or 1 (gelu_pk)");
    bf16_t* O; int ldc; const float* bias; int split_cols; size_t split_stride; float scale0;
    __device__ __forceinline__ void operator()(const f32x4 (&acc)[2][2][4][2], const Unit& u, int wr, int wc, int fr, int fq) const {
        const int row0 = u.pm * BM + wr * 64 + fr; int colt = u.pn * BM; bf16_t* base = O;
        float sc = 1.f; if (split_cols) { const int t = colt / split_cols; base += (size_t)t * split_stride; colt -= t * split_cols; if (t == 0) sc = scale0; }
        const int col0 = colt + wc * 32 + 8 * fq, bcol0 = u.pn * BM + wc * 32 + 8 * fq;
        f32x4 bv[2][2];
#pragma unroll
        for (int bj = 0; bj < 2; ++bj)
#pragma unroll
            for (int n = 0; n < 2; ++n) bv[bj][n] = bias ? *(const f32x4*)(bias + bcol0 + bj * HALF + 4 * n) : (f32x4){0.f, 0.f, 0.f, 0.f};
#pragma unroll
        for (int ai = 0; ai < 2; ++ai)
#pragma unroll
            for (int m = 0; m < 4; ++m) { bf16_t* rowp = base + (size_t)(row0 + ai * HALF + m * 16) * ldc + col0;
#pragma unroll
                for (int bj = 0; bj < 2; ++bj) { f32x4 v0 = acc[ai][bj][m][0] + bv[bj][0], v1 = acc[ai][bj][m][1] + bv[bj][1];
                    if (ACT == 1) { f32x2 a = gelu_pk((f32x2){v0[0], v0[1]}), b = gelu_pk((f32x2){v0[2], v0[3]}), c = gelu_pk((f32x2){v1[0], v1[1]}), d = gelu_pk((f32x2){v1[2], v1[3]});
                        v0 = (f32x4){a.x, a.y, b.x, b.y}; v1 = (f32x4){c.x, c.y, d.x, d.y}; }
                    v0 = v0 * sc; v1 = v1 * sc; u32x4 w; w.x = cvt_pk_bf16(v0[0], v0[1]); w.y = cvt_pk_bf16(v0[2], v0[3]); w.z = cvt_pk_bf16(v1[0], v1[1]); w.w = cvt_pk_bf16(v1[2], v1[3]);
                    *(u32x4*)(rowp + bj * HALF) = w; } }
    }
};

template <int MODE> struct EpiMy {
    static constexpr bool PERM = true, AFTER_DRAIN = false;
    bf16_t* O; int ldc; int ncv; float* ssq;
    __device__ __forceinline__ void operator()(const f32x4 (&acc)[2][2][4][2], const Unit& u, int wr, int wc, int fr, int fq) const {
        const int row0 = u.pm * BM + wr * 64 + fr; const int col0 = u.pn * BM + wc * 32 + 8 * fq;
#pragma unroll
        for (int ai = 0; ai < 2; ++ai)
#pragma unroll
            for (int m = 0; m < 4; ++m) {
                const int row = row0 + ai * HALF + m * 16;
                bf16_t* rowp = O + (size_t)row * ldc + col0;
                float ss = 0.f;
#pragma unroll
                for (int bj = 0; bj < 2; ++bj) {
                    f32x4 v0 = acc[ai][bj][m][0], v1 = acc[ai][bj][m][1];
                    if (MODE == 1) {
#pragma unroll
                        for (int e = 0; e < 4; ++e) { const float a0 = fmaxf(v0[e], 0.f), a1 = fmaxf(v1[e], 0.f); v0[e] = a0 * a0; v1[e] = a1 * a1; }
                    }
                    if (MODE == 2) ss += (v0[0] * v0[0] + v0[1] * v0[1]) + (v0[2] * v0[2] + v0[3] * v0[3]) + (v1[0] * v1[0] + v1[1] * v1[1]) + (v1[2] * v1[2] + v1[3] * v1[3]);
                    u32x4 w; w.x = cvt_pk_bf16(v0[0], v0[1]); w.y = cvt_pk_bf16(v0[2], v0[3]); w.z = cvt_pk_bf16(v1[0], v1[1]); w.w = cvt_pk_bf16(v1[2], v1[3]);
                    if (col0 + bj * HALF < ncv) *(u32x4*)(rowp + bj * HALF) = w;
                }
                if (MODE == 2) { ss += __shfl_xor(ss, 16); ss += __shfl_xor(ss, 32); if (fq == 0) unsafeAtomicAdd(ssq + row, ss); }
            }
    }
};
template <class Epi, class Sched, bool ALIGN_EPI = false, bool SP2 = false>
__device__ __forceinline__ void gemm_phase(PG8_LAS unsigned char* lds, const Gemm g, const Sched& S, const Epi& E) {
    int tid_l_ = threadIdx.x; asm volatile("" : "+v"(tid_l_)); const int tid = tid_l_, wid = __builtin_amdgcn_readfirstlane(tid >> 6), lane = tid & 63, wr = wid >> 2, wc = wid & 3, fr = lane & 15, fq = lane >> 4;
    int Kl_ = g.K; asm volatile("" : "+s"(Kl_)); const int K = Kl_, nt = K / BK;
    unsigned voffA[2], voffB[2];
#pragma unroll
    for (int i = 0; i < 2; ++i) { int R, C; stage_rc(tid * 16 + i * 8192, R, C); const int Rb = Epi::PERM ? ((R & ~31) + perm32(R & 31)) : R;
        voffA[i] = (unsigned)(R * K + C) * 2u; voffB[i] = (unsigned)(Rb * K + C) * 2u; }
    const size_t kstep = (size_t)(BK * 2);
    const size_t hstep = (size_t)HALF * K * 2;
    const size_t tstep = 2 * hstep;
    const unsigned ldsw = (unsigned)wid * 1024u;
    const int aoff = lds_byte(wr * 64 + fr, fq * 8), boff = lds_byte(wc * 32 + fr, fq * 8);
#define PG8_SA(b, h) (((b) * 2 + (h)) * HTB)
#define PG8_SB(b, h) ((4 + (b) * 2 + (h)) * HTB)
#define PG8_STAGE(bufoff, gbase, voff) do { _Pragma("unroll") for (int _i = 0; _i < 2; ++_i) \
        __builtin_amdgcn_global_load_lds((const unsigned*)((const char*)(gbase) + (voff)[_i]), (PG8_LAS unsigned*)(lds + (bufoff) + ldsw + _i * 8192), 16, 0, 0); } while (0)
#define PG8_LDA(dst, b, h) do { _Pragma("unroll") for (int m = 0; m < 4; ++m) _Pragma("unroll") for (int k = 0; k < 2; ++k) dst[m][k] = *(const PG8_LAS bf16x8*)(lds + PG8_SA(b, h) + aoff + m * 2048 + k * 1024); } while (0)
#define PG8_LDB(dst, b, h) do { _Pragma("unroll") for (int n = 0; n < 2; ++n) _Pragma("unroll") for (int k = 0; k < 2; ++k) dst[n][k] = *(const PG8_LAS bf16x8*)(lds + PG8_SB(b, h) + boff + n * 2048 + k * 1024); } while (0)
#define PG8_MMA(ai, bj, At, Bt) do { __builtin_amdgcn_s_setprio(1); _Pragma("unroll") for (int m = 0; m < 4; ++m) _Pragma("unroll") for (int n = 0; n < 2; ++n) _Pragma("unroll") for (int k = 0; k < 2; ++k) \
        acc[ai][bj][m][n] = __builtin_amdgcn_mfma_f32_16x16x32_bf16(Bt[n][k], At[m][k], acc[ai][bj][m][n], 0, 0, 0); __builtin_amdgcn_s_setprio(0); } while (0)
#define PG8_WAIT_V(n) asm volatile("s_waitcnt vmcnt(" #n ")" ::: "memory")
#define PG8_WAIT_L(n) asm volatile("s_waitcnt lgkmcnt(" #n ")" ::: "memory")
#define PG8_BAR __builtin_amdgcn_s_barrier()
#define PG8_SCHED __builtin_amdgcn_sched_barrier(0)
    Unit cur, nxt; int ui = 0;
    if (!S.next(0, cur)) return;
    f32x4 acc[2][2][4][2];
#pragma unroll
    for (int a = 0; a < 2; ++a)
#pragma unroll
        for (int b = 0; b < 2; ++b)
#pragma unroll
            for (int m = 0; m < 4; ++m)
#pragma unroll
                for (int n = 0; n < 2; ++n) acc[a][b][m][n] = (f32x4){0.f, 0.f, 0.f, 0.f};
    bf16x8 At[4][2], B0[2][2], B1[2][2];
    const char* cA = (const char*)g.A + (size_t)cur.pm * tstep; const char* cB = (const char*)g.Bt + (size_t)cur.pn * tstep;
    S.a_ready(cur);
    if constexpr (SP2) {
        PG8_STAGE(PG8_SB(0, 0), cB, voffB); PG8_STAGE(PG8_SB(0, 1), cB + hstep, voffB); PG8_STAGE(PG8_SA(0, 0), cA, voffA); PG8_STAGE(PG8_SA(0, 1), cA + hstep, voffA);
        if (wr == 1) PG8_BAR;
        PG8_WAIT_V(2); PG8_BAR;
        PG8_STAGE(PG8_SB(1, 0), cB + kstep, voffB); PG8_STAGE(PG8_SA(1, 0), cA + kstep, voffA); PG8_STAGE(PG8_SB(1, 1), cB + hstep + kstep, voffB);
        PG8_WAIT_V(6); PG8_BAR;
    } else {
        PG8_STAGE(PG8_SB(0, 0), cB, voffB); PG8_STAGE(PG8_SA(0, 0), cA, voffA); PG8_STAGE(PG8_SB(0, 1), cB + hstep, voffB); PG8_STAGE(PG8_SA(0, 1), cA + hstep, voffA);
        if (wr == 1) PG8_BAR;
        PG8_WAIT_V(4); PG8_BAR;
        PG8_STAGE(PG8_SB(1, 0), cB + kstep, voffB); PG8_STAGE(PG8_SA(1, 0), cA + kstep, voffA); PG8_STAGE(PG8_SB(1, 1), cB + hstep + kstep, voffB);
        PG8_WAIT_V(6); PG8_BAR;
    }
    for (;;) {
        const bool has_next = S.next(ui + 1, nxt);
        const char* nA = has_next ? (const char*)g.A + (size_t)nxt.pm * tstep : cA; const char* nB = has_next ? (const char*)g.Bt + (size_t)nxt.pn * tstep : cB;
        for (int t = 0; t < nt; t += 2) {
            const bool last = (t == nt - 2);
            const char* a1 = cA + (size_t)(t + 1) * kstep;
            const char* a2 = last ? nA : cA + (size_t)(t + 2) * kstep; const char* b2 = last ? nB : cB + (size_t)(t + 2) * kstep;
            const char* a3 = a2 + kstep; const char* b3 = b2 + kstep;
            if (last && has_next) S.a_ready(nxt);
            if constexpr (SP2) {
            PG8_LDB(B0, 0, 0); PG8_LDB(B1, 0, 1); PG8_SCHED; PG8_LDA(At, 0, 0); PG8_STAGE(PG8_SA(1, 1), a1 + hstep, voffA);
            PG8_WAIT_V(8); PG8_WAIT_L(0); PG8_BAR; PG8_MMA(0, 0, At, B0); PG8_MMA(0, 1, At, B1); PG8_BAR; PG8_SCHED;
            PG8_LDA(At, 0, 1); PG8_STAGE(PG8_SB(0, 0), b2, voffB); PG8_STAGE(PG8_SB(0, 1), b2 + hstep, voffB); PG8_STAGE(PG8_SA(0, 0), a2, voffA);
            PG8_WAIT_V(8); PG8_WAIT_L(0); PG8_BAR; PG8_MMA(1, 0, At, B0); PG8_MMA(1, 1, At, B1); PG8_BAR; PG8_SCHED;
            PG8_LDB(B0, 1, 0); PG8_LDB(B1, 1, 1); PG8_SCHED; PG8_LDA(At, 1, 0); PG8_STAGE(PG8_SA(0, 1), a2 + hstep, voffA);
            PG8_WAIT_V(8); PG8_WAIT_L(0); PG8_BAR; PG8_MMA(0, 0, At, B0); PG8_MMA(0, 1, At, B1); PG8_BAR; PG8_SCHED;
            PG8_LDA(At, 1, 1); PG8_STAGE(PG8_SB(1, 0), b3, voffB); PG8_STAGE(PG8_SB(1, 1), b3 + hstep, voffB); PG8_STAGE(PG8_SA(1, 0), a3, voffA);
            PG8_WAIT_V(8); PG8_WAIT_L(0); PG8_BAR; PG8_MMA(1, 0, At, B0); PG8_MMA(1, 1, At, B1); PG8_BAR; PG8_SCHED;
            } else {
            PG8_LDB(B0, 0, 0); PG8_SCHED; PG8_LDA(At, 0, 0); PG8_STAGE(PG8_SA(1, 1), a1 + hstep, voffA);
            PG8_WAIT_L(8); PG8_BAR; PG8_WAIT_L(0); PG8_MMA(0, 0, At, B0); PG8_BAR; PG8_SCHED;
            PG8_LDB(B1, 0, 1); PG8_STAGE(PG8_SB(0, 0), b2, voffB);
            PG8_BAR; PG8_WAIT_L(0); PG8_MMA(0, 1, At, B1); PG8_BAR;
            PG8_LDA(At, 0, 1); PG8_STAGE(PG8_SA(0, 0), a2, voffA);
            PG8_BAR; PG8_WAIT_L(0); PG8_MMA(1, 0, At, B0); PG8_BAR; PG8_SCHED;
            PG8_STAGE(PG8_SB(0, 1), b2 + hstep, voffB);
            PG8_WAIT_V(6); PG8_BAR; PG8_MMA(1, 1, At, B1); PG8_BAR;
            PG8_LDB(B0, 1, 0); PG8_SCHED; PG8_LDA(At, 1, 0); PG8_STAGE(PG8_SA(0, 1), a2 + hstep, voffA);
            PG8_WAIT_L(8); PG8_BAR; PG8_WAIT_L(0); PG8_MMA(0, 0, At, B0); PG8_BAR; PG8_SCHED;
            PG8_LDB(B1, 1, 1); PG8_STAGE(PG8_SB(1, 0), b3, voffB);
            PG8_BAR; PG8_WAIT_L(0); PG8_MMA(0, 1, At, B1); PG8_BAR;
            PG8_LDA(At, 1, 1); PG8_STAGE(PG8_SA(1, 0), a3, voffA);
            PG8_BAR; PG8_WAIT_L(0); PG8_MMA(1, 0, At, B0); PG8_BAR; PG8_SCHED;
            PG8_STAGE(PG8_SB(1, 1), b3 + hstep, voffB);
            PG8_WAIT_V(6); PG8_BAR; PG8_MMA(1, 1, At, B1); PG8_BAR;
            }
        }
        if constexpr (ALIGN_EPI) { if (wr == 0) PG8_BAR; }
        if constexpr (!Epi::AFTER_DRAIN) { E(acc, cur, wr, wc, fr, fq); S.done(cur); }
        if (!has_next) break;
#pragma unroll
        for (int a = 0; a < 2; ++a)
#pragma unroll
            for (int b = 0; b < 2; ++b)
#pragma unroll
                for (int m = 0; m < 4; ++m)
#pragma unroll
                    for (int n = 0; n < 2; ++n) acc[a][b][m][n] = (f32x4){0.f, 0.f, 0.f, 0.f};
        cur = nxt; cA = nA; cB = nB; ++ui;
        if constexpr (ALIGN_EPI) { if (wr == 1) PG8_BAR; }
    }
    PG8_WAIT_V(0);
    if constexpr (!ALIGN_EPI) { if (wr == 0) PG8_BAR; }
    PG8_BAR;
    if constexpr (Epi::AFTER_DRAIN) { E.fused(acc, cur, wr, wc, fr, fq, lds, wid, lane); S.done(cur); }
#undef PG8_SA
#undef PG8_SB
#undef PG8_STAGE
#undef PG8_LDA
#undef PG8_LDB
#undef PG8_MMA
#undef PG8_WAIT_V
#undef PG8_WAIT_L
#undef PG8_BAR
#undef PG8_SCHED
}
}

namespace cg = cooperative_groups;
#define LAS __attribute__((address_space(3)))
typedef unsigned short bf16;
typedef float f32x4 __attribute__((ext_vector_type(4)));
typedef float f32x2 __attribute__((ext_vector_type(2)));
typedef short bf16x8 __attribute__((ext_vector_type(8)));
typedef short s16x4 __attribute__((ext_vector_type(4)));
typedef unsigned u32x4 __attribute__((ext_vector_type(4)));
typedef unsigned u32x2 __attribute__((ext_vector_type(2)));
#define LDS_WAIT() asm volatile("s_waitcnt lgkmcnt(0)" ::: "memory")

constexpr int NT = 98304, NTP = 65536, DM = 1024, ZW = 3200, ZWP = 3328, FFD = 4096, NTH = NT / 2;
constexpr size_t MiB = 1u << 20;
constexpr size_t WS_CTLB = 65536;
constexpr size_t CNT_OFF = 32768;
constexpr size_t WS_WIN = 2 * MiB, WS_WOUT = 15 * MiB, WS_W1 = 19 * MiB, WS_W2 = 35 * MiB, WS_HB = 52 * MiB, WS_ZB = 244 * MiB, WS_HID = 244 * MiB,
                 WS_RAW = 628 * MiB, WS_YB = 844 * MiB, WS_END = 1012 * MiB;
constexpr int LDS_BYTES = 147456;
constexpr int N_SCAN_UNITS = 192, N_ATTN_UNITS = 2304;

struct Args { const float* in[25]; float* out; unsigned char* ws; };
typedef const __attribute__((address_space(4))) Args CArgs;
#define KARGS() ({ CArgs* p_ = (CArgs*)__builtin_amdgcn_kernarg_segment_ptr(); asm volatile("" : "+s"(p_)); p_; })

__device__ __forceinline__ float bf2f(unsigned short u) { return __uint_as_float((unsigned)u << 16); }
__device__ __forceinline__ unsigned f2bf(float f) { unsigned u = __float_as_uint(f); return (u + 0x7fffu + ((u >> 16) & 1u)) >> 16; }
__device__ __forceinline__ unsigned pk2(float lo, float hi) { return f2bf(lo) | (f2bf(hi) << 16); }
__device__ __forceinline__ float wave_sum(float v) {
#pragma unroll
    for (int o = 1; o < 64; o <<= 1) v += __shfl_xor(v, o);
    return v;
}
__device__ __forceinline__ float sigm(float x) { return __builtin_amdgcn_rcpf(1.f + __expf(-x)); }
__device__ __forceinline__ float tanh_(float x) { const float e = __expf(2.f * x); return 1.f - 2.f * __builtin_amdgcn_rcpf(e + 1.f); }
#define DPP_F(v, ctrl) __int_as_float(__builtin_amdgcn_update_dpp(0, __float_as_int(v), (ctrl), 0xF, 0xF, true))
__device__ __forceinline__ float red8(float v) { v += DPP_F(v, 0xB1); v += DPP_F(v, 0x4E); v += DPP_F(v, 0x141); return v; }
__device__ __forceinline__ float wave_sum_fast(float v) {
    v += DPP_F(v, 0xB1); v += DPP_F(v, 0x4E); v += DPP_F(v, 0x141); v += DPP_F(v, 0x140);
    const int vi = __float_as_int(v);
    const float s0 = __int_as_float(__builtin_amdgcn_readlane(vi, 0)), s1 = __int_as_float(__builtin_amdgcn_readlane(vi, 16)), s2 = __int_as_float(__builtin_amdgcn_readlane(vi, 32)), s3 = __int_as_float(__builtin_amdgcn_readlane(vi, 48));
    return (s0 + s1) + (s2 + s3);
}
__device__ __forceinline__ void seq_of(int m, int& T, int& seqbase, int& t) {
    if (m < NTP) { T = 4096; t = m & 4095; } else { T = 2048; t = (m - NTP) & 2047; }
    seqbase = m - t;
}

__device__ __forceinline__ void transpose_item(const float* W, int K, int N, bf16* WT, LAS float* scr, int item, int lane) {
    const int nblk = N / 32, kb = item / nblk, nb = item % nblk, k0 = 64 * kb, n0 = 32 * nb;
    float wv_[32];
#pragma unroll
    for (int i = 0; i < 32; ++i) wv_[i] = W[(size_t)(k0 + 2 * i + (lane >> 5)) * N + n0 + (lane & 31)];
#pragma unroll
    for (int i = 0; i < 32; ++i) scr[(2 * i + (lane >> 5)) * 33 + (lane & 31)] = wv_[i];
    LDS_WAIT();
    const int c = lane & 7;
#pragma unroll
    for (int j = 0; j < 4; ++j) { const int n = (lane >> 3) + 8 * j; const LAS float* s = scr + (8 * c) * 33 + n;
        u32x4 o; o.x = pk2(s[0 * 33], s[1 * 33]); o.y = pk2(s[2 * 33], s[3 * 33]); o.z = pk2(s[4 * 33], s[5 * 33]); o.w = pk2(s[6 * 33], s[7 * 33]);
        *(u32x4*)(WT + (size_t)(n0 + n) * K + k0 + 8 * c) = o; }
    LDS_WAIT();
}
__device__ __forceinline__ void convert_weights(LAS unsigned char* lds, CArgs* ap, int l0, int l1, int wi, int nw, int lane, int wave) {
    LAS float* scr = (LAS float*)(lds + wave * 16384);
    bf16* WIN = (bf16*)(ap->ws + WS_WIN); bf16* WOUT = (bf16*)(ap->ws + WS_WOUT); bf16* W1 = (bf16*)(ap->ws + WS_W1); bf16* W2 = (bf16*)(ap->ws + WS_W2);
    constexpr int I_IN = 16 * 100, I_OUT = 16 * 32, I_1 = 16 * 128, I_2 = 64 * 32, I_L = I_IN + I_OUT + I_1 + I_2;
    for (int it = l0 * I_L + wi; it < l1 * I_L; it += nw) {
        const int l = it / I_L; int r = it % I_L;
        if (r < I_IN) { transpose_item(ap->in[7] + (size_t)l * DM * ZW, DM, ZW, WIN + (size_t)l * ZWP * DM, scr, r, lane); continue; } r -= I_IN;
        if (r < I_OUT) { transpose_item(ap->in[8] + (size_t)l * DM * DM, DM, DM, WOUT + (size_t)l * DM * DM, scr, r, lane); continue; } r -= I_OUT;
        if (r < I_1) { transpose_item(ap->in[23] + (size_t)l * DM * FFD, DM, FFD, W1 + (size_t)l * FFD * DM, scr, r, lane); continue; } r -= I_1;
        transpose_item(ap->in[24] + (size_t)l * FFD * DM, FFD, DM, W2 + (size_t)l * DM * FFD, scr, r, lane);
    }
}
__device__ __forceinline__ void phase_prologue(LAS unsigned char* lds, CArgs* ap, int gw, int NGW, int lane, int wave) {
    bf16* WIN = (bf16*)(ap->ws + WS_WIN);
    convert_weights(lds, ap, 0, ((int)gridDim.x > N_SCAN_UNITS) ? 1 : 2, gw, NGW, lane, wave);
    for (int i = gw * 64 + lane; i < 2 * 16384; i += NGW * 64) { const int l = i >> 14, o = i & 16383;
        *(u32x4*)(WIN + (size_t)l * ZWP * DM + (size_t)ZW * DM + (size_t)o * 8) = (u32x4){0u, 0u, 0u, 0u}; }
}

__device__ __forceinline__ void phase_norm0(const float* xp, const float* xs, const float* g, bf16* HB, int gw, int NGW, int lane) {
    f32x4 vn[4];
#define N0_LOAD(m_) do { const int mm_ = (m_); const float* xr_ = (mm_ < NTP) ? xp + (size_t)mm_ * DM : xs + (size_t)(mm_ - NTP) * DM; \
        _Pragma("unroll") for (int j = 0; j < 4; ++j) vn[j] = *(const f32x4*)(xr_ + 4 * lane + 256 * j); } while (0)
    if (gw < NT) N0_LOAD(gw);
#pragma unroll 1
    for (int m = gw; m < NT; m += NGW) {
        f32x4 v[4]; float ss = 0.f;
#pragma unroll
        for (int j = 0; j < 4; ++j) { v[j] = vn[j]; ss += (v[j].x * v[j].x + v[j].y * v[j].y) + (v[j].z * v[j].z + v[j].w * v[j].w); }
        if (m + NGW < NT) N0_LOAD(m + NGW);
        ss = wave_sum_fast(ss); const float rs = rsqrtf(ss * (1.f / DM) + 1e-6f);
#pragma unroll
        for (int j = 0; j < 4; ++j) { const f32x4 gg = *(const f32x4*)(g + 4 * lane + 256 * j);
            u32x2 o; o.x = pk2(v[j].x * rs * gg.x, v[j].y * rs * gg.y); o.y = pk2(v[j].z * rs * gg.z, v[j].w * rs * gg.w);
            *(u32x2*)(HB + (size_t)m * DM + 4 * lane + 256 * j) = o; }
    }
#undef N0_LOAD
}
__device__ __forceinline__ void phase_resid(const float* xp, const float* xs, bool from_in, float* out, const bf16* RAW, const float* gpost, const float* gnext, bf16* HB,
                                            int gw, int NGW, int lane) {
    u32x2 rwn[4]; f32x4 xn[4];
#define RS_LOAD(m_) do { const int mm_ = (m_); const float* xr_ = from_in ? ((mm_ < NTP) ? xp + (size_t)mm_ * DM : xs + (size_t)(mm_ - NTP) * DM) : out + (size_t)mm_ * DM; \
        _Pragma("unroll") for (int j = 0; j < 4; ++j) { rwn[j] = *(const u32x2*)(RAW + (size_t)mm_ * DM + 4 * lane + 256 * j); xn[j] = *(const f32x4*)(xr_ + 4 * lane + 256 * j); } } while (0)
    if (gw < NT) RS_LOAD(gw);
#pragma unroll 1
    for (int m = gw; m < NT; m += NGW) {
        u32x2 rw[4]; f32x4 x[4];
#pragma unroll
        for (int j = 0; j < 4; ++j) { rw[j] = rwn[j]; x[j] = xn[j]; }
        if (m + NGW < NT) RS_LOAD(m + NGW);
        f32x4 r[4]; float sr = 0.f;
#pragma unroll
        for (int j = 0; j < 4; ++j) {
            r[j].x = __uint_as_float(rw[j].x << 16); r[j].y = __uint_as_float(rw[j].x & 0xffff0000u); r[j].z = __uint_as_float(rw[j].y << 16); r[j].w = __uint_as_float(rw[j].y & 0xffff0000u);
            sr += (r[j].x * r[j].x + r[j].y * r[j].y) + (r[j].z * r[j].z + r[j].w * r[j].w); }
        sr = wave_sum_fast(sr); const float rs = rsqrtf(sr * (1.f / DM) + 1e-6f);
        f32x4 v[4]; float ss = 0.f;
#pragma unroll
        for (int j = 0; j < 4; ++j) {
            const f32x4 gp = *(const f32x4*)(gpost + 4 * lane + 256 * j);
            v[j] = x[j] + r[j] * rs * gp;
            ss += (v[j].x * v[j].x + v[j].y * v[j].y) + (v[j].z * v[j].z + v[j].w * v[j].w);
            *(f32x4*)(out + (size_t)m * DM + 4 * lane + 256 * j) = v[j];
        }
        if (gnext) {
            ss = wave_sum_fast(ss); const float rs2 = rsqrtf(ss * (1.f / DM) + 1e-6f);
#pragma unroll
            for (int j = 0; j < 4; ++j) { const f32x4 gg = *(const f32x4*)(gnext + 4 * lane + 256 * j);
                u32x2 o; o.x = pk2(v[j].x * rs2 * gg.x, v[j].y * rs2 * gg.y); o.y = pk2(v[j].z * rs2 * gg.z, v[j].w * rs2 * gg.w);
                *(u32x2*)(HB + (size_t)m * DM + 4 * lane + 256 * j) = o; }
        }
    }
#undef RS_LOAD
}

__device__ __forceinline__ float bflo(unsigned u) { return __uint_as_float(u << 16); }
__device__ __forceinline__ float bfhi(unsigned u) { return __uint_as_float(u & 0xffff0000u); }
__device__ __forceinline__ void unpack8(const u32x4 w, float (&f)[8]) { f[0] = bflo(w.x); f[1] = bfhi(w.x); f[2] = bflo(w.y); f[3] = bfhi(w.y); f[4] = bflo(w.z); f[5] = bfhi(w.z); f[6] = bflo(w.w); f[7] = bfhi(w.w); }
__device__ __forceinline__ u32x4 pack8(const float (&f)[8]) { u32x4 w; w.x = pk2(f[0], f[1]); w.y = pk2(f[2], f[3]); w.z = pk2(f[4], f[5]); w.w = pk2(f[6], f[7]); return w; }
__device__ __forceinline__ void unpack4(const u32x2 w, float (&f)[4]) { f[0] = bflo(w.x); f[1] = bfhi(w.x); f[2] = bflo(w.y); f[3] = bfhi(w.y); }
#define SC_TOK(p, c) (((p) >> 4) ? (T - 1 - (16 * (c) + ((p) & 15))) : (16 * (c) + ((p) & 15)))
#define DPP_SHR(v, n) __int_as_float(__builtin_amdgcn_update_dpp(0, __float_as_int(v), 0x110 + (n), 0xF, 0xF, true))
constexpr int SCB = 21504;
__device__ __forceinline__ void scan_unit(LAS unsigned char* lds, const bf16* ZB, float* YB, CArgs* ap, int l, int su, int tid, int lane, int wave) {
    const int seq = su / 6, h = su % 6;
    int T, seqbase; if (seq < 16) { T = 4096; seqbase = seq * 4096; } else { T = 2048; seqbase = NTP + (seq - 16) * 2048; }
    const int dir = wave >> 2, q = wave & 3, x = lane & 15, kg = lane >> 4;
    LAS unsigned short* YLh = (LAS unsigned short*)lds;
#define TWLB(p) ((LAS unsigned short*)(lds + 8192 + (dir * 2 + (p)) * 2304))
    const int hcq = h * 64 + 16 * q, c0 = hcq + 4 * kg;
    const f32x4 zf = (f32x4){0.f, 0.f, 0.f, 0.f};
    bf16x8 Ww, Wa;
    {   const float* dup = ap->in[14] + (size_t)(l * 2 + dir) * 32 * 384; const float* iup = ap->in[16] + (size_t)(l * 2 + dir) * 32 * 384; float t8[8];
#pragma unroll
        for (int e = 0; e < 8; ++e) t8[e] = dup[(8 * kg + e) * 384 + hcq + x];
        Ww = __builtin_bit_cast(bf16x8, pack8(t8));
#pragma unroll
        for (int e = 0; e < 8; ++e) t8[e] = iup[(8 * kg + e) * 384 + hcq + x];
        Wa = __builtin_bit_cast(bf16x8, pack8(t8)); }
    const float* mu = ap->in[12] + l * 1280;
    const f32x4 w0v = *(const f32x4*)(ap->in[13] + (l * 2 + dir) * 384 + c0), a0v = *(const f32x4*)(ap->in[15] + (l * 2 + dir) * 384 + c0);
    const f32x4 kkv = *(const f32x4*)(ap->in[18] + l * 384 + c0), kav = *(const f32x4*)(ap->in[19] + l * 384 + c0);
    const f32x4 murv = *(const f32x4*)(mu + c0), mukv = *(const f32x4*)(mu + 384 + c0), muvv = *(const f32x4*)(mu + 768 + c0);
    const float muwq0 = mu[1152 + 8 * kg + 2 * q], muwq1 = mu[1153 + 8 * kg + 2 * q], muaq0 = mu[1184 + 8 * kg + 2 * q], muaq1 = mu[1185 + 8 * kg + 2 * q];
    const bf16* zrow0 = ZB + (size_t)seqbase * ZW;
    const bf16* zero_row = (const bf16*)ap->ws;
    const int p1 = tid >> 4, q1 = tid & 15, nch = T / 16;
    f32x4 ST[4];
#pragma unroll
    for (int jt = 0; jt < 4; ++jt) ST[jt] = zf;
    u32x2 zrA_[3][3], zrB_[3][3]; unsigned bwA_[3], baA_[3], bwB_[3], baB_[3];
    const u32x4 z4 = (u32x4){0u, 0u, 0u, 0u}; const u32x2 z2 = (u32x2){0u, 0u}; (void)z4; (void)z2;
#define SC_ROWS(c) const int t_ = SC_TOK(dir * 16 + x, (c)); const bf16* zc_ = zrow0 + (size_t)t_ * ZW; \
        const bf16* zp_ = (t_ > 0) ? zc_ - ZW : zero_row; const bf16* zn_ = (t_ < T - 1) ? zc_ + ZW : zero_row
#define SC_LOAD(ZR, c) do { SC_ROWS(c); \
        _Pragma("unroll") for (int qq = 0; qq < 3; ++qq) { ZR[1][qq] = *(const u32x2*)(zc_ + 1920 + 384 * qq + c0); ZR[0][qq] = *(const u32x2*)(zp_ + 1920 + 384 * qq + c0); ZR[2][qq] = *(const u32x2*)(zn_ + 1920 + 384 * qq + c0); } } while (0)
#define SC_LOAD0(BW, BA, c) do { SC_ROWS(c); BW[1] = *(const unsigned*)(zc_ + 3072 + 8 * kg + 2 * q); BW[0] = *(const unsigned*)(zp_ + 3072 + 8 * kg + 2 * q); BW[2] = *(const unsigned*)(zn_ + 3072 + 8 * kg + 2 * q); \
        BA[1] = *(const unsigned*)(zc_ + 3104 + 8 * kg + 2 * q); BA[0] = *(const unsigned*)(zp_ + 3104 + 8 * kg + 2 * q); BA[2] = *(const unsigned*)(zn_ + 3104 + 8 * kg + 2 * q); } while (0)
#define SC_B0(BW, BA, par) do { LAS unsigned short* tw_ = TWLB(par); \
        const float w0_ = tanh_(bflo(BW[1]) + (0.5f * (bflo(BW[0]) + bflo(BW[2])) - bflo(BW[1])) * muwq0), w1_ = tanh_(bfhi(BW[1]) + (0.5f * (bfhi(BW[0]) + bfhi(BW[2])) - bfhi(BW[1])) * muwq1); \
        const float a0_ = bflo(BA[1]) + (0.5f * (bflo(BA[0]) + bflo(BA[2])) - bflo(BA[1])) * muaq0, a1_ = bfhi(BA[1]) + (0.5f * (bfhi(BA[0]) + bfhi(BA[2])) - bfhi(BA[1])) * muaq1; \
        *(LAS unsigned*)(tw_ + x * 72 + 8 * kg + 2 * q) = HWPK(w0_, w1_); *(LAS unsigned*)(tw_ + x * 72 + 32 + 8 * kg + 2 * q) = HWPK(a0_, a1_); } while (0)
#define CBUF3(i) (lds + 17408 + (dir * 3 + (i)) * SCB)
#define P_CAT(cb) ((LAS unsigned short*)(cb))
#define P_CRT(cb) ((LAS unsigned short*)((cb) + 2304))
#define P_CBT(cb) ((LAS unsigned short*)((cb) + 4608))
#define P_CKT(cb) ((LAS unsigned short*)((cb) + 6912))
#define P_CBJ(cb) ((LAS unsigned short*)((cb) + 9216))
#define P_CKJ(cb) ((LAS unsigned short*)((cb) + 11776))
#define P_CBM(cb) ((LAS unsigned short*)((cb) + 14336))
#define P_CTT(cb) ((LAS unsigned short*)((cb) + 14976))
#define P_CAY(cb) ((LAS unsigned short*)((cb) + 15616))
#define P_CBY(cb) ((LAS unsigned short*)((cb) + 16256))
#define P_AFT(cb) ((LAS float*)((cb) + 16896))
#define P_CGC(cb) ((LAS float*)((cb) + 17984))
#define P_CVI(cb) ((LAS unsigned short*)((cb) + 18240))
#define P_NP(cb) ((LAS float*)((cb) + 20800))
#define SC_BAR() do { asm volatile("s_waitcnt lgkmcnt(0)" ::: "memory"); __builtin_amdgcn_s_barrier(); asm volatile("" ::: "memory"); } while (0)
#define HWPK(lo, hi) pg8::cvt_pk_bf16((lo), (hi))
    SC_LOAD(zrA_, 0); SC_LOAD(zrB_, min(1, nch - 1));
    SC_LOAD0(bwA_, baA_, 0); SC_B0(bwA_, baA_, 0); SC_LOAD0(bwA_, baA_, min(1, nch - 1)); SC_LOAD0(bwB_, baB_, min(2, nch - 1));
    SC_BAR();
    float rr[4], vv[4], lw[4], av[4], kq[4], kd[4];
    int r0 = 0;
#pragma unroll 1
    for (int k0 = -3; k0 < nch; k0 += 2) {
      { const int k = k0;
        const int r1 = (r0 == 2) ? 0 : r0 + 1, r2 = (r1 == 2) ? 0 : r1 + 1;
        {
            LAS unsigned char* cb = CBUF3(r2);
            const LAS float* NP = P_NP(cb);
            const float n2t = (NP[x] + NP[16 + x]) + (NP[32 + x] + NP[48 + x]); const float rnm = __builtin_amdgcn_rcpf(fmaxf(sqrtf(n2t), 1e-12f));
            float at[4], rt[4], bt[4], kt[4], gg[4];
#pragma unroll
            for (int e = 0; e < 4; ++e) { const float kk = kq[e] * rnm, bb = kk * av[e];
                float L = lw[e]; L += DPP_SHR(L, 1); L += DPP_SHR(L, 2); L += DPP_SHR(L, 4); L += DPP_SHR(L, 8);
                const float g = __expf(L), gm = __expf(L - lw[e]), gi = __expf(-L);
                at[e] = -kk * gm; rt[e] = rr[e] * g; bt[e] = bb * gi; kt[e] = kd[e] * gi; gg[e] = g; }
            u32x2 w2;
            w2.x = HWPK(at[0], at[1]); w2.y = HWPK(at[2], at[3]); *(LAS u32x2*)(P_CAT(cb) + x * 72 + 16 * q + 4 * kg) = w2;
            w2.x = HWPK(rt[0], rt[1]); w2.y = HWPK(rt[2], rt[3]); *(LAS u32x2*)(P_CRT(cb) + x * 72 + 16 * q + 4 * kg) = w2;
            const unsigned b01 = HWPK(bt[0], bt[1]), b23 = HWPK(bt[2], bt[3]), k01 = HWPK(kt[0], kt[1]), k23 = HWPK(kt[2], kt[3]), v01 = HWPK(vv[0], vv[1]), v23 = HWPK(vv[2], vv[3]);
            w2.x = b01; w2.y = b23; *(LAS u32x2*)(P_CBT(cb) + x * 72 + 16 * q + 4 * kg) = w2;
            w2.x = k01; w2.y = k23; *(LAS u32x2*)(P_CKT(cb) + x * 72 + 16 * q + 4 * kg) = w2;
            {   const int jr = 16 * q + 4 * kg; LAS unsigned short* bj = P_CBJ(cb) + jr * 20 + x; LAS unsigned short* kj = P_CKJ(cb) + jr * 20 + x; LAS unsigned short* vi = P_CVI(cb) + jr * 20 + x;
                bj[0] = (unsigned short)(b01 & 0xffffu); bj[20] = (unsigned short)(b01 >> 16); bj[40] = (unsigned short)(b23 & 0xffffu); bj[60] = (unsigned short)(b23 >> 16);
                kj[0] = (unsigned short)(k01 & 0xffffu); kj[20] = (unsigned short)(k01 >> 16); kj[40] = (unsigned short)(k23 & 0xffffu); kj[60] = (unsigned short)(k23 >> 16);
                vi[0] = (unsigned short)(v01 & 0xffffu); vi[20] = (unsigned short)(v01 >> 16); vi[40] = (unsigned short)(v23 & 0xffffu); vi[60] = (unsigned short)(v23 >> 16); }
            if (x == 15) *(LAS f32x4*)(P_CGC(cb) + 16 * q + 4 * kg) = (f32x4){gg[0], gg[1], gg[2], gg[3]};
        }
        {
            LAS unsigned char* cb = CBUF3(r0);
            const LAS unsigned short* tw = TWLB((k + 3) & 1);
            const bf16x8 TWb = *(const LAS bf16x8*)(tw + x * 72 + 8 * kg), TAb = *(const LAS bf16x8*)(tw + x * 72 + 32 + 8 * kg);
            const f32x4 Cw = __builtin_amdgcn_mfma_f32_16x16x32_bf16(Ww, TWb, zf, 0, 0, 0), Ca = __builtin_amdgcn_mfma_f32_16x16x32_bf16(Wa, TAb, zf, 0, 0, 0);
            float rc[4], rp[4], rn[4], kc[4], kp[4], kn[4], vc[4], vp[4], vn[4];
            unpack4(zrA_[1][0], rc); unpack4(zrA_[0][0], rp); unpack4(zrA_[2][0], rn); unpack4(zrA_[1][1], kc); unpack4(zrA_[0][1], kp); unpack4(zrA_[2][1], kn);
            unpack4(zrA_[1][2], vc); unpack4(zrA_[0][2], vp); unpack4(zrA_[2][2], vn);
            float n2 = 0.f;
#pragma unroll
            for (int e = 0; e < 4; ++e) {
                rr[e] = rc[e] + (0.5f * (rp[e] + rn[e]) - rc[e]) * murv[e]; const float kk0 = kc[e] + (0.5f * (kp[e] + kn[e]) - kc[e]) * mukv[e]; vv[e] = vc[e] + (0.5f * (vp[e] + vn[e]) - vc[e]) * muvv[e];
                lw[e] = -0.6065306597f * sigm(w0v[e] + Cw[e]); av[e] = sigm(a0v[e] + Ca[e]);
                kq[e] = kk0 * kkv[e]; n2 += kq[e] * kq[e]; kd[e] = kk0 * (1.f + (av[e] - 1.f) * kav[e]);
            }
            n2 += __shfl_xor(n2, 16); n2 += __shfl_xor(n2, 32);
            if (kg == 0) P_NP(cb)[q * 16 + x] = n2;
        }
        SC_LOAD(zrA_, min(k + 5, nch - 1));
        SC_B0(bwA_, baA_, (k + 4) & 1); SC_LOAD0(bwA_, baA_, min(k + 6, nch - 1));
        {
            LAS unsigned char* cb = CBUF3(r1);
            const int rq = (q - dir) & 3;
            const LAS unsigned short* F = (rq < 2) ? P_CAT(cb) : P_CRT(cb); const LAS unsigned short* S2 = (rq & 1) ? P_CKT(cb) : P_CBT(cb);
            const bf16x8 F0 = *(const LAS bf16x8*)(F + x * 72 + 8 * kg), F1 = *(const LAS bf16x8*)(F + x * 72 + 32 + 8 * kg);
            const bf16x8 S0 = *(const LAS bf16x8*)(S2 + x * 72 + 8 * kg), S1 = *(const LAS bf16x8*)(S2 + x * 72 + 32 + 8 * kg);
            f32x4 G = __builtin_amdgcn_mfma_f32_16x16x32_bf16(F0, S0, zf, 0, 0, 0); G = __builtin_amdgcn_mfma_f32_16x16x32_bf16(F1, S1, G, 0, 0, 0);
            if (rq == 0) {
#define SC_PROD(FI, SE) ({ f32x4 a_ = zf; a_ = __builtin_amdgcn_mfma_f32_16x16x4f32((FI)[0], (SE)[0], a_, 0, 0, 0); a_ = __builtin_amdgcn_mfma_f32_16x16x4f32((FI)[1], (SE)[1], a_, 0, 0, 0); \
                    a_ = __builtin_amdgcn_mfma_f32_16x16x4f32((FI)[2], (SE)[2], a_, 0, 0, 0); a_ = __builtin_amdgcn_mfma_f32_16x16x4f32((FI)[3], (SE)[3], a_, 0, 0, 0); a_; })
                f32x4 Gc = __builtin_amdgcn_mfma_f32_16x16x32_bf16(S0, F0, zf, 0, 0, 0); Gc = __builtin_amdgcn_mfma_f32_16x16x32_bf16(S1, F1, Gc, 0, 0, 0);
                f32x4 R1, C1, CT;
#pragma unroll
                for (int e = 0; e < 4; ++e) { const int y_ = 4 * kg + e; R1[e] = (x < y_) ? G[e] : 0.f; C1[e] = (y_ < x) ? Gc[e] : 0.f; CT[e] = C1[e] + ((y_ == x) ? 1.f : 0.f); }
                const f32x4 R2 = SC_PROD(C1, R1), C2 = SC_PROD(R1, C1);
                CT = CT + SC_PROD(R2, CT);
                const f32x4 R4 = SC_PROD(C2, R2), C4 = SC_PROD(R2, C2);
                CT = CT + SC_PROD(R4, CT);
                const f32x4 R8 = SC_PROD(C4, R4);
                CT = CT + SC_PROD(R8, CT);
#undef SC_PROD
                u32x2 wt; wt.x = pk2(CT[0], CT[1]); wt.y = pk2(CT[2], CT[3]);
                *(LAS u32x2*)(P_CTT(cb) + x * 20 + 4 * kg) = wt;
            } else {
                LAS unsigned short* D = (rq == 1) ? P_CBM(cb) : ((rq == 2) ? P_CAY(cb) : P_CBY(cb));
#pragma unroll
                for (int e = 0; e < 4; ++e) { const int sx = 4 * kg + e; const bool keep = (rq == 1) ? (x < sx) : (x <= sx); D[sx * 20 + x] = (unsigned short)f2bf(keep ? G[e] : 0.f); }
            }
        }
        {
            LAS unsigned char* cb = CBUF3(r0);
            u32x4 t4;
            t4.x = HWPK(ST[0][0], ST[0][1]); t4.y = HWPK(ST[0][2], ST[0][3]); t4.z = HWPK(ST[1][0], ST[1][1]); t4.w = HWPK(ST[1][2], ST[1][3]);
            const bf16x8 SO0 = __builtin_bit_cast(bf16x8, t4);
            t4.x = HWPK(ST[2][0], ST[2][1]); t4.y = HWPK(ST[2][2], ST[2][3]); t4.z = HWPK(ST[3][0], ST[3][1]); t4.w = HWPK(ST[3][2], ST[3][3]);
            const bf16x8 SO1 = __builtin_bit_cast(bf16x8, t4);
#define SC_JOP(base, ks) ({ const u32x2 lo_ = *(const LAS u32x2*)((base) + x * 72 + 32 * (ks) + 4 * kg), hi_ = *(const LAS u32x2*)((base) + x * 72 + 32 * (ks) + 16 + 4 * kg); u32x4 w_; w_.x = lo_.x; w_.y = lo_.y; w_.z = hi_.x; w_.w = hi_.y; __builtin_bit_cast(bf16x8, w_); })
#define SC_UOP(base, row) ({ const u32x2 lo_ = *(const LAS u32x2*)((base) + (row) * 20 + 4 * kg); u32x4 w_; w_.x = lo_.x; w_.y = lo_.y; w_.z = 0u; w_.w = 0u; __builtin_bit_cast(bf16x8, w_); })
#define SC_COP(v) ({ u32x4 w_; w_.x = pk2((v)[0], (v)[1]); w_.y = pk2((v)[2], (v)[3]); w_.z = 0u; w_.w = 0u; __builtin_bit_cast(bf16x8, w_); })
            f32x4 RH = __builtin_amdgcn_mfma_f32_16x16x32_bf16(SC_JOP(P_CAT(cb), 0), SO0, zf, 0, 0, 0); RH = __builtin_amdgcn_mfma_f32_16x16x32_bf16(SC_JOP(P_CAT(cb), 1), SO1, RH, 0, 0, 0);
            const bf16x8 VO = SC_UOP(P_CVI(cb), 16 * q + x);
            RH = __builtin_amdgcn_mfma_f32_16x16x32_bf16(SC_UOP(P_CBM(cb), x), VO, RH, 0, 0, 0);
            const bf16x8 RO = SC_COP(RH);
            const f32x4 SA = __builtin_amdgcn_mfma_f32_16x16x32_bf16(SC_UOP(P_CTT(cb), x), RO, zf, 0, 0, 0);
            const bf16x8 SAO = SC_COP(SA);
            f32x4 Y = __builtin_amdgcn_mfma_f32_16x16x32_bf16(SC_JOP(P_CRT(cb), 0), SO0, zf, 0, 0, 0); Y = __builtin_amdgcn_mfma_f32_16x16x32_bf16(SC_JOP(P_CRT(cb), 1), SO1, Y, 0, 0, 0);
            Y = __builtin_amdgcn_mfma_f32_16x16x32_bf16(SC_UOP(P_CAY(cb), x), SAO, Y, 0, 0, 0); Y = __builtin_amdgcn_mfma_f32_16x16x32_bf16(SC_UOP(P_CBY(cb), x), VO, Y, 0, 0, 0);
#pragma unroll
            for (int e = 0; e < 4; ++e) (YLh + ((k & 1) ? 2048 : 0))[(dir * 16 + 4 * kg + e) * 64 + 16 * q + x] = (unsigned short)f2bf(Y[e]);
#pragma unroll
            for (int jt = 0; jt < 4; ++jt) {
                ST[jt] = __builtin_amdgcn_mfma_f32_16x16x32_bf16(SC_UOP(P_CBJ(cb), 16 * jt + x), SAO, ST[jt], 0, 0, 0);
                ST[jt] = __builtin_amdgcn_mfma_f32_16x16x32_bf16(SC_UOP(P_CKJ(cb), 16 * jt + x), VO, ST[jt], 0, 0, 0);
                ST[jt] = ST[jt] * *(const LAS f32x4*)(P_CGC(cb) + 16 * jt + 4 * kg);
            }
#undef SC_JOP
#undef SC_UOP
#undef SC_COP
        }
        if (k < 0) {
#pragma unroll
            for (int jt = 0; jt < 4; ++jt) ST[jt] = zf; }
        if (k >= 1) {
            const int cc = k - 1;
            const int t = SC_TOK(p1, cc); bf16* dst = (bf16*)YB + (size_t)(p1 >> 4) * NT * 384 + (size_t)(seqbase + t) * 384 + h * 64 + 4 * q1; const u32x2 w = *(const LAS u32x2*)(YLh + ((cc & 1) ? 2048 : 0) + p1 * 64 + 4 * q1);
            *(u32x2*)dst = w;
        }
        SC_BAR();
        r0 = r1;
      }
      { const int k = k0 + 1;
        const int r1 = (r0 == 2) ? 0 : r0 + 1, r2 = (r1 == 2) ? 0 : r1 + 1;
        {
            LAS unsigned char* cb = CBUF3(r2);
            const LAS float* NP = P_NP(cb);
            const float n2t = (NP[x] + NP[16 + x]) + (NP[32 + x] + NP[48 + x]); const float rnm = __builtin_amdgcn_rcpf(fmaxf(sqrtf(n2t), 1e-12f));
            float at[4], rt[4], bt[4], kt[4], gg[4];
#pragma unroll
            for (int e = 0; e < 4; ++e) { const float kk = kq[e] * rnm, bb = kk * av[e];
                float L = lw[e]; L += DPP_SHR(L, 1); L += DPP_SHR(L, 2); L += DPP_SHR(L, 4); L += DPP_SHR(L, 8);
                const float g = __expf(L), gm = __expf(L - lw[e]), gi = __expf(-L);
                at[e] = -kk * gm; rt[e] = rr[e] * g; bt[e] = bb * gi; kt[e] = kd[e] * gi; gg[e] = g; }
            u32x2 w2;
            w2.x = HWPK(at[0], at[1]); w2.y = HWPK(at[2], at[3]); *(LAS u32x2*)(P_CAT(cb) + x * 72 + 16 * q + 4 * kg) = w2;
            w2.x = HWPK(rt[0], rt[1]); w2.y = HWPK(rt[2], rt[3]); *(LAS u32x2*)(P_CRT(cb) + x * 72 + 16 * q + 4 * kg) = w2;
            const unsigned b01 = HWPK(bt[0], bt[1]), b23 = HWPK(bt[2], bt[3]), k01 = HWPK(kt[0], kt[1]), k23 = HWPK(kt[2], kt[3]), v01 = HWPK(vv[0], vv[1]), v23 = HWPK(vv[2], vv[3]);
            w2.x = b01; w2.y = b23; *(LAS u32x2*)(P_CBT(cb) + x * 72 + 16 * q + 4 * kg) = w2;
            w2.x = k01; w2.y = k23; *(LAS u32x2*)(P_CKT(cb) + x * 72 + 16 * q + 4 * kg) = w2;
            {   const int jr = 16 * q + 4 * kg; LAS unsigned short* bj = P_CBJ(cb) + jr * 20 + x; LAS unsigned short* kj = P_CKJ(cb) + jr * 20 + x; LAS unsigned short* vi = P_CVI(cb) + jr * 20 + x;
                bj[0] = (unsigned short)(b01 & 0xffffu); bj[20] = (unsigned short)(b01 >> 16); bj[40] = (unsigned short)(b23 & 0xffffu); bj[60] = (unsigned short)(b23 >> 16);
                kj[0] = (unsigned short)(k01 & 0xffffu); kj[20] = (unsigned short)(k01 >> 16); kj[40] = (unsigned short)(k23 & 0xffffu); kj[60] = (unsigned short)(k23 >> 16);
                vi[0] = (unsigned short)(v01 & 0xffffu); vi[20] = (unsigned short)(v01 >> 16); vi[40] = (unsigned short)(v23 & 0xffffu); vi[60] = (unsigned short)(v23 >> 16); }
            if (x == 15) *(LAS f32x4*)(P_CGC(cb) + 16 * q + 4 * kg) = (f32x4){gg[0], gg[1], gg[2], gg[3]};
        }
        {
            LAS unsigned char* cb = CBUF3(r0);
            const LAS unsigned short* tw = TWLB((k + 3) & 1);
            const bf16x8 TWb = *(const LAS bf16x8*)(tw + x * 72 + 8 * kg), TAb = *(const LAS bf16x8*)(tw + x * 72 + 32 + 8 * kg);
            const f32x4 Cw = __builtin_amdgcn_mfma_f32_16x16x32_bf16(Ww, TWb, zf, 0, 0, 0), Ca = __builtin_amdgcn_mfma_f32_16x16x32_bf16(Wa, TAb, zf, 0, 0, 0);
            float rc[4], rp[4], rn[4], kc[4], kp[4], kn[4], vc[4], vp[4], vn[4];
            unpack4(zrB_[1][0], rc); unpack4(zrB_[0][0], rp); unpack4(zrB_[2][0], rn); unpack4(zrB_[1][1], kc); unpack4(zrB_[0][1], kp); unpack4(zrB_[2][1], kn);
            unpack4(zrB_[1][2], vc); unpack4(zrB_[0][2], vp); unpack4(zrB_[2][2], vn);
            float n2 = 0.f;
#pragma unroll
            for (int e = 0; e < 4; ++e) {
                rr[e] = rc[e] + (0.5f * (rp[e] + rn[e]) - rc[e]) * murv[e]; const float kk0 = kc[e] + (0.5f * (kp[e] + kn[e]) - kc[e]) * mukv[e]; vv[e] = vc[e] + (0.5f * (vp[e] + vn[e]) - vc[e]) * muvv[e];
                lw[e] = -0.6065306597f * sigm(w0v[e] + Cw[e]); av[e] = sigm(a0v[e] + Ca[e]);
                kq[e] = kk0 * kkv[e]; n2 += kq[e] * kq[e]; kd[e] = kk0 * (1.f + (av[e] - 1.f) * kav[e]);
            }
            n2 += __shfl_xor(n2, 16); n2 += __shfl_xor(n2, 32);
            if (kg == 0) P_NP(cb)[q * 16 + x] = n2;
        }
        SC_LOAD(zrB_, min(k + 5, nch - 1));
        SC_B0(bwB_, baB_, (k + 4) & 1); SC_LOAD0(bwB_, baB_, min(k + 6, nch - 1));
        {
            LAS unsigned char* cb = CBUF3(r1);
            const int rq = (q - dir) & 3;
            const LAS unsigned short* F = (rq < 2) ? P_CAT(cb) : P_CRT(cb); const LAS unsigned short* S2 = (rq & 1) ? P_CKT(cb) : P_CBT(cb);
            const bf16x8 F0 = *(const LAS bf16x8*)(F + x * 72 + 8 * kg), F1 = *(const LAS bf16x8*)(F + x * 72 + 32 + 8 * kg);
            const bf16x8 S0 = *(const LAS bf16x8*)(S2 + x * 72 + 8 * kg), S1 = *(const LAS bf16x8*)(S2 + x * 72 + 32 + 8 * kg);
            f32x4 G = __builtin_amdgcn_mfma_f32_16x16x32_bf16(F0, S0, zf, 0, 0, 0); G = __builtin_amdgcn_mfma_f32_16x16x32_bf16(F1, S1, G, 0, 0, 0);
            if (rq == 0) {
#define SC_PROD(FI, SE) ({ f32x4 a_ = zf; a_ = __builtin_amdgcn_mfma_f32_16x16x4f32((FI)[0], (SE)[0], a_, 0, 0, 0); a_ = __builtin_amdgcn_mfma_f32_16x16x4f32((FI)[1], (SE)[1], a_, 0, 0, 0); \
                    a_ = __builtin_amdgcn_mfma_f32_16x16x4f32((FI)[2], (SE)[2], a_, 0, 0, 0); a_ = __builtin_amdgcn_mfma_f32_16x16x4f32((FI)[3], (SE)[3], a_, 0, 0, 0); a_; })
                f32x4 Gc = __builtin_amdgcn_mfma_f32_16x16x32_bf16(S0, F0, zf, 0, 0, 0); Gc = __builtin_amdgcn_mfma_f32_16x16x32_bf16(S1, F1, Gc, 0, 0, 0);
                f32x4 R1, C1, CT;
#pragma unroll
                for (int e = 0; e < 4; ++e) { const int y_ = 4 * kg + e; R1[e] = (x < y_) ? G[e] : 0.f; C1[e] = (y_ < x) ? Gc[e] : 0.f; CT[e] = C1[e] + ((y_ == x) ? 1.f : 0.f); }
                const f32x4 R2 = SC_PROD(C1, R1), C2 = SC_PROD(R1, C1);
                CT = CT + SC_PROD(R2, CT);
                const f32x4 R4 = SC_PROD(C2, R2), C4 = SC_PROD(R2, C2);
                CT = CT + SC_PROD(R4, CT);
                const f32x4 R8 = SC_PROD(C4, R4);
                CT = CT + SC_PROD(R8, CT);
#undef SC_PROD
                u32x2 wt; wt.x = pk2(CT[0], CT[1]); wt.y = pk2(CT[2], CT[3]);
                *(LAS u32x2*)(P_CTT(cb) + x * 20 + 4 * kg) = wt;
            } else {
                LAS unsigned short* D = (rq == 1) ? P_CBM(cb) : ((rq == 2) ? P_CAY(cb) : P_CBY(cb));
#pragma unroll
                for (int e = 0; e < 4; ++e) { const int sx = 4 * kg + e; const bool keep = (rq == 1) ? (x < sx) : (x <= sx); D[sx * 20 + x] = (unsigned short)f2bf(keep ? G[e] : 0.f); }
            }
        }
        {
            LAS unsigned char* cb = CBUF3(r0);
            u32x4 t4;
            t4.x = HWPK(ST[0][0], ST[0][1]); t4.y = HWPK(ST[0][2], ST[0][3]); t4.z = HWPK(ST[1][0], ST[1][1]); t4.w = HWPK(ST[1][2], ST[1][3]);
            const bf16x8 SO0 = __builtin_bit_cast(bf16x8, t4);
            t4.x = HWPK(ST[2][0], ST[2][1]); t4.y = HWPK(ST[2][2], ST[2][3]); t4.z = HWPK(ST[3][0], ST[3][1]); t4.w = HWPK(ST[3][2], ST[3][3]);
            const bf16x8 SO1 = __builtin_bit_cast(bf16x8, t4);
#define SC_JOP(base, ks) ({ const u32x2 lo_ = *(const LAS u32x2*)((base) + x * 72 + 32 * (ks) + 4 * kg), hi_ = *(const LAS u32x2*)((base) + x * 72 + 32 * (ks) + 16 + 4 * kg); u32x4 w_; w_.x = lo_.x; w_.y = lo_.y; w_.z = hi_.x; w_.w = hi_.y; __builtin_bit_cast(bf16x8, w_); })
#define SC_UOP(base, row) ({ const u32x2 lo_ = *(const LAS u32x2*)((base) + (row) * 20 + 4 * kg); u32x4 w_; w_.x = lo_.x; w_.y = lo_.y; w_.z = 0u; w_.w = 0u; __builtin_bit_cast(bf16x8, w_); })
#define SC_COP(v) ({ u32x4 w_; w_.x = pk2((v)[0], (v)[1]); w_.y = pk2((v)[2], (v)[3]); w_.z = 0u; w_.w = 0u; __builtin_bit_cast(bf16x8, w_); })
            f32x4 RH = __builtin_amdgcn_mfma_f32_16x16x32_bf16(SC_JOP(P_CAT(cb), 0), SO0, zf, 0, 0, 0); RH = __builtin_amdgcn_mfma_f32_16x16x32_bf16(SC_JOP(P_CAT(cb), 1), SO1, RH, 0, 0, 0);
            const bf16x8 VO = SC_UOP(P_CVI(cb), 16 * q + x);
            RH = __builtin_amdgcn_mfma_f32_16x16x32_bf16(SC_UOP(P_CBM(cb), x), VO, RH, 0, 0, 0);
            const bf16x8 RO = SC_COP(RH);
            const f32x4 SA = __builtin_amdgcn_mfma_f32_16x16x32_bf16(SC_UOP(P_CTT(cb), x), RO, zf, 0, 0, 0);
            const bf16x8 SAO = SC_COP(SA);
            f32x4 Y = __builtin_amdgcn_mfma_f32_16x16x32_bf16(SC_JOP(P_CRT(cb), 0), SO0, zf, 0, 0, 0); Y = __builtin_amdgcn_mfma_f32_16x16x32_bf16(SC_JOP(P_CRT(cb), 1), SO1, Y, 0, 0, 0);
            Y = __builtin_amdgcn_mfma_f32_16x16x32_bf16(SC_UOP(P_CAY(cb), x), SAO, Y, 0, 0, 0); Y = __builtin_amdgcn_mfma_f32_16x16x32_bf16(SC_UOP(P_CBY(cb), x), VO, Y, 0, 0, 0);
#pragma unroll
            for (int e = 0; e < 4; ++e) (YLh + ((k & 1) ? 2048 : 0))[(dir * 16 + 4 * kg + e) * 64 + 16 * q + x] = (unsigned short)f2bf(Y[e]);
#pragma unroll
            for (int jt = 0; jt < 4; ++jt) {
                ST[jt] = __builtin_amdgcn_mfma_f32_16x16x32_bf16(SC_UOP(P_CBJ(cb), 16 * jt + x), SAO, ST[jt], 0, 0, 0);
                ST[jt] = __builtin_amdgcn_mfma_f32_16x16x32_bf16(SC_UOP(P_CKJ(cb), 16 * jt + x), VO, ST[jt], 0, 0, 0);
                ST[jt] = ST[jt] * *(const LAS f32x4*)(P_CGC(cb) + 16 * jt + 4 * kg);
            }
#undef SC_JOP
#undef SC_UOP
#undef SC_COP
        }
        if (k < 0) {
#pragma unroll
            for (int jt = 0; jt < 4; ++jt) ST[jt] = zf; }
        if (k >= 1) {
            const int cc = k - 1;
            const int t = SC_TOK(p1, cc); bf16* dst = (bf16*)YB + (size_t)(p1 >> 4) * NT * 384 + (size_t)(seqbase + t) * 384 + h * 64 + 4 * q1; const u32x2 w = *(const LAS u32x2*)(YLh + ((cc & 1) ? 2048 : 0) + p1 * 64 + 4 * q1);
            *(u32x2*)dst = w;
        }
        SC_BAR();
        r0 = r1;
      }
    }
#undef SC_LOAD
#undef SC_LOAD0
#undef SC_B0
#undef SC_ROWS
#undef TWLB
}

constexpr int AT_OACC = 0, AT_M = 256 * 68 * 4, AT_L = AT_M + 1024, AT_VT = AT_L + 1024, AT_VT_W = 64 * 36 * 2, AT_BT = AT_VT + 8 * AT_VT_W, AT_END = AT_BT + 18 * 176 * 4;
static_assert(AT_END <= LDS_BYTES - 64 && 17408 + 6 * SCB <= LDS_BYTES - 64, "attention / scan LDS maps");
__device__ __forceinline__ void attn_unit(LAS unsigned char* lds, const bf16* ZB, bf16* HB, const bf16* zero_row, int u, int tid, int lane, int wave) {
    LAS float* OACC = (LAS float*)(lds + AT_OACC); LAS float* MACC = (LAS float*)(lds + AT_M); LAS float* LACC = (LAS float*)(lds + AT_L);
    LAS unsigned* VTw = (LAS unsigned*)(lds + AT_VT + wave * AT_VT_W); LAS unsigned short* VTh = (LAS unsigned short*)VTw; const LAS float* BT = (const LAS float*)(lds + AT_BT);
    const int h = u % 6, rg = u / 6, mg = rg * 256;
    int T, seqbase, t0; seq_of(mg, T, seqbase, t0);
    const bf16* zseq = ZB + (size_t)seqbase * ZW;
    const int qi = lane & 15, kg = lane >> 4;
    for (int br = 0; br < 3; ++br) {
        const int sh = 2 * br, L = T >> sh;
        const LAS float* bt = BT + (br * 6 + h) * 176 + (4 * kg - qi + 15);
        for (int jj = 0; jj < 2; ++jj) {
            const int j = wave * 2 + jj;
            int c, m0;
            if (br == 0) { c = 0; m0 = t0 + 16 * j; } else if (br == 1) { c = j & 3; m0 = (t0 >> 2) + 16 * (j >> 2); } else { c = j; m0 = t0 >> 4; }
            const int tq = ((m0 + qi) << sh) + c;
            const bool edge = (m0 < 64) || (m0 + 96 > L);
            const bf16* qp = zseq + (size_t)tq * ZW + h * 64 + 8 * kg;
            const bf16x8 Q0 = *(const bf16x8*)qp, Q1 = *(const bf16x8*)(qp + 32);
            float lg[10][4];
            float mx = -1e30f;
            bf16x8 Kf[10][2];
#pragma unroll
            for (int jt = 0; jt < 10; ++jt) {
                const int kw = m0 - 64 + 16 * jt + qi; const bool kv = (kw >= 0) && (kw < L);
                const bf16* kp = (kv ? zseq + (size_t)((kw << sh) + c) * ZW : zero_row) + 384 + h * 64 + 8 * kg;
                Kf[jt][0] = *(const bf16x8*)kp; Kf[jt][1] = *(const bf16x8*)(kp + 32);
            }
#pragma unroll
            for (int jt = 0; jt < 10; ++jt) {
                f32x4 s = (f32x4){0.f, 0.f, 0.f, 0.f};
                s = __builtin_amdgcn_mfma_f32_16x16x32_bf16(Kf[jt][0], Q0, s, 0, 0, 0);
                s = __builtin_amdgcn_mfma_f32_16x16x32_bf16(Kf[jt][1], Q1, s, 0, 0, 0);
#pragma unroll
                for (int e = 0; e < 4; ++e) lg[jt][e] = s[e] * 0.125f + bt[16 * jt + e];
            }
            if (edge) {
#pragma unroll
                for (int jt = 0; jt < 10; ++jt)
#pragma unroll
                    for (int e = 0; e < 4; ++e) { const int kw2 = m0 - 64 + 16 * jt + 4 * kg + e; if (!((kw2 >= 0) && (kw2 < L))) lg[jt][e] = -1e30f; }
            }
#pragma unroll
            for (int jt = 0; jt < 10; ++jt)
#pragma unroll
                for (int e = 0; e < 4; ++e) mx = fmaxf(mx, lg[jt][e]);
            mx = fmaxf(mx, __shfl_xor(mx, 16)); mx = fmaxf(mx, __shfl_xor(mx, 32));
            float lsum = 0.f;
#pragma unroll
            for (int jt = 0; jt < 10; ++jt)
#pragma unroll
                for (int e = 0; e < 4; ++e) { const float p = __expf(lg[jt][e] - mx); lg[jt][e] = p; lsum += p; }
            lsum += __shfl_xor(lsum, 16); lsum += __shfl_xor(lsum, 32);
            f32x4 Oa[4];
#pragma unroll
            for (int dt = 0; dt < 4; ++dt) Oa[dt] = (f32x4){0.f, 0.f, 0.f, 0.f};
            u32x4 vxa[2], vxb[2];
#define AT_VLOAD(kt_) do { _Pragma("unroll") for (int u2 = 0; u2 < 2; ++u2) { const int pid = lane + 64 * u2, rp = pid & 15, dc = pid >> 4; \
                    const int kwa = m0 - 64 + 32 * (kt_) + 2 * rp, kwb = kwa + 1; const bool va = (kwa >= 0) && (kwa < L), vb = (kwb >= 0) && (kwb < L); \
                    const bf16* pa_ = va ? zseq + (size_t)((kwa << sh) + c) * ZW : zero_row; const bf16* pb_ = vb ? zseq + (size_t)((kwb << sh) + c) * ZW : zero_row; \
                    vxa[u2] = *(const u32x4*)(pa_ + 768 + h * 64 + 8 * dc); vxb[u2] = *(const u32x4*)(pb_ + 768 + h * 64 + 8 * dc); } } while (0)
            AT_VLOAD(0);
#pragma unroll
            for (int kt = 0; kt < 5; ++kt) {
#pragma unroll
                for (int u2 = 0; u2 < 2; ++u2) {
                    const int pid = lane + 64 * u2, rp = pid & 15, dc = pid >> 4;
                    const u32x4 xa = vxa[u2], xb = vxb[u2];
                    LAS unsigned* wp = VTw + (8 * dc) * 18 + rp;
                    wp[0 * 18] = __builtin_amdgcn_perm(xb.x, xa.x, 0x05040100u); wp[1 * 18] = __builtin_amdgcn_perm(xb.x, xa.x, 0x07060302u);
                    wp[2 * 18] = __builtin_amdgcn_perm(xb.y, xa.y, 0x05040100u); wp[3 * 18] = __builtin_amdgcn_perm(xb.y, xa.y, 0x07060302u);
                    wp[4 * 18] = __builtin_amdgcn_perm(xb.z, xa.z, 0x05040100u); wp[5 * 18] = __builtin_amdgcn_perm(xb.z, xa.z, 0x07060302u);
                    wp[6 * 18] = __builtin_amdgcn_perm(xb.w, xa.w, 0x05040100u); wp[7 * 18] = __builtin_amdgcn_perm(xb.w, xa.w, 0x07060302u);
                }
                if (kt < 4) AT_VLOAD(kt + 1);
                LDS_WAIT();
                u32x4 pw; pw.x = pg8::cvt_pk_bf16(lg[2 * kt][0], lg[2 * kt][1]); pw.y = pg8::cvt_pk_bf16(lg[2 * kt][2], lg[2 * kt][3]); pw.z = pg8::cvt_pk_bf16(lg[2 * kt + 1][0], lg[2 * kt + 1][1]); pw.w = pg8::cvt_pk_bf16(lg[2 * kt + 1][2], lg[2 * kt + 1][3]);
                const bf16x8 Pf = __builtin_bit_cast(bf16x8, pw);
#pragma unroll
                for (int dt = 0; dt < 4; ++dt) {
                    const LAS unsigned short* rp_ = VTh + (16 * dt + qi) * 36 + 4 * kg;
                    const u32x2 lo = *(const LAS u32x2*)rp_, hi = *(const LAS u32x2*)(rp_ + 16);
                    u32x4 aw; aw.x = lo.x; aw.y = lo.y; aw.z = hi.x; aw.w = hi.y;
                    Oa[dt] = __builtin_amdgcn_mfma_f32_16x16x32_bf16(__builtin_bit_cast(bf16x8, aw), Pf, Oa[dt], 0, 0, 0);
                }
                LDS_WAIT();
            }
#undef AT_VLOAD
            const int tok = tq - t0; LAS float* op = OACC + tok * 68 + 4 * kg;
            if (br == 0) {
#pragma unroll
                for (int dt = 0; dt < 4; ++dt) *(LAS f32x4*)(op + 16 * dt) = Oa[dt];
                if (kg == 0) { MACC[tok] = mx; LACC[tok] = lsum; }
            } else {
                const float mo = MACC[tok], lo_ = LACC[tok]; const float mn = fmaxf(mo, mx); const float so = __expf(mo - mn), sc = __expf(mx - mn);
#pragma unroll
                for (int dt = 0; dt < 4; ++dt) { f32x4 o = *(LAS f32x4*)(op + 16 * dt); o = o * so + Oa[dt] * sc; *(LAS f32x4*)(op + 16 * dt) = o; }
                LDS_WAIT();
                if (kg == 0) { MACC[tok] = mn; LACC[tok] = lo_ * so + lsum * sc; }
            }
        }
        __syncthreads();
    }
    {
        const int tok = tid >> 1, half = tid & 1; const float inv = 1.f / LACC[tok]; const LAS float* op = OACC + tok * 68 + 32 * half;
        bf16* dst = HB + (size_t)(mg + tok) * DM + h * 64 + 32 * half;
#pragma unroll
        for (int q = 0; q < 4; ++q) { const f32x4 x0 = *(const LAS f32x4*)(op + 8 * q), x1 = *(const LAS f32x4*)(op + 8 * q + 4);
            u32x4 w; w.x = pk2(x0.x * inv, x0.y * inv); w.y = pk2(x0.z * inv, x0.w * inv); w.z = pk2(x1.x * inv, x1.y * inv); w.w = pk2(x1.z * inv, x1.w * inv);
            *(u32x4*)(dst + 8 * q) = w; }
    }
    __syncthreads();
}
__device__ __forceinline__ int t5_bucket_dev(int rd) {
    const int n = rd < 0 ? -rd : rd; const int ret = rd > 0 ? 16 : 0;
    const int v = n < 8 ? n : (n < 15 ? 8 : (n < 27 ? 9 : (n < 50 ? 10 : (n < 91 ? 11 : (n < 166 ? 12 : (n < 305 ? 13 : (n < 559 ? 14 : 15)))))));
    return ret + v;
}
__device__ __forceinline__ void phase_mixers(LAS unsigned char* lds, const bf16* ZB, float* YB, bf16* HB, CArgs* ap, int l, unsigned* counter, int tid, int lane, int wave) {
#ifdef SPLIT_MIX
    const unsigned long long tsm0_ = __builtin_amdgcn_s_memrealtime();
#endif
#ifndef NO_SCAN
    for (int su = blockIdx.x; su < N_SCAN_UNITS; su += gridDim.x) { scan_unit(lds, ZB, YB, ap, l, su, tid, lane, wave); __syncthreads(); }
#endif
#ifdef SPLIT_MIX
    cg::this_grid().sync();
#ifndef SPLIT_NOSPIN
    { const unsigned long long t1_ = __builtin_amdgcn_s_memrealtime(); const unsigned long long dt_ = t1_ - tsm0_; while (__builtin_amdgcn_s_memrealtime() - t1_ < dt_) __builtin_amdgcn_s_sleep(8); cg::this_grid().sync(); }
#endif
#endif
    if (l == 0 && (int)blockIdx.x >= N_SCAN_UNITS && (int)gridDim.x > N_SCAN_UNITS) {
        convert_weights(lds, ap, 1, 2, ((int)blockIdx.x - N_SCAN_UNITS) * 8 + wave, ((int)gridDim.x - N_SCAN_UNITS) * 8, lane, wave);
        __syncthreads(); }
    {   LAS float* BT = (LAS float*)(lds + AT_BT); const float* rb = ap->in[2];
        for (int i = tid; i < 3 * 6 * 176; i += 512) { const int br = i / (6 * 176), rem = i % (6 * 176), h = rem / 176, ri = rem % 176; const int rel = ri - 79;
            BT[(br * 6 + h) * 176 + ri] = (rel >= -64 && rel <= 64) ? rb[t5_bucket_dev(rel * (1 << (2 * br))) * 6 + h] : -1e30f; } }
    __syncthreads();
    LAS int* flag = (LAS int*)(lds + LDS_BYTES - 16);
#ifndef ATTN_REPS
#define ATTN_REPS 1
#endif
#pragma unroll 1
    for (int rep = 0; rep < ATTN_REPS; ++rep)
    for (;;) {
        if (tid == 0) *flag = (int)atomicAdd(counter + 16 * rep, 1u);
        __syncthreads();
        const int u = *flag;
        __syncthreads();
        if (u >= N_ATTN_UNITS) break;
#ifndef NO_ATTN
        attn_unit(lds, ZB, HB, (const bf16*)ap->ws, u, tid, lane, wave);
#endif
    }
}

constexpr int FN_AUPT = 0, FN_GUPT = 768 * 80, FN_END = FN_GUPT + 384 * 144;
static_assert(FN_END + 4992 * 4 <= LDS_BYTES - 64, "final-phase LDS map");
__device__ __forceinline__ void phase_final(LAS unsigned char* lds, const bf16* ZB, const float* YB, bf16* HB, CArgs* ap, int l, int gw, int NGW, int tid, int lane, int wave) {
    LAS unsigned short* AUPT = (LAS unsigned short*)(lds + FN_AUPT); LAS unsigned short* GUPT = (LAS unsigned short*)(lds + FN_GUPT);
    {   const float* aup = ap->in[16] + (size_t)l * 2 * 32 * 384;
#pragma unroll 1
        for (int i0 = tid; i0 < 2 * 32 * 384; i0 += 512 * 24) { float v8[24];
#pragma unroll
            for (int k = 0; k < 24; ++k) v8[k] = aup[i0 + 512 * k];
#pragma unroll
            for (int k = 0; k < 24; ++k) { const int i = i0 + 512 * k; const int c = i % 384, r = (i / 384) & 31, d = i / (384 * 32); AUPT[(d * 384 + c) * 40 + r] = (unsigned short)f2bf(v8[k]); } }
        const float* gup = ap->in[17] + (size_t)l * 64 * 384;
#pragma unroll 1
        for (int i0 = tid; i0 < 64 * 384; i0 += 512 * 24) { float v8[24];
#pragma unroll
            for (int k = 0; k < 24; ++k) v8[k] = gup[i0 + 512 * k];
#pragma unroll
            for (int k = 0; k < 24; ++k) { const int i = i0 + 512 * k; const int c = i % 384, r = i / 384; GUPT[c * 72 + r] = (unsigned short)f2bf(v8[k]); } } }
    LAS float* PL = (LAS float*)(lds + FN_END);
    {   const float* src[9] = {ap->in[12] + l * 1280, ap->in[15] + l * 768, ap->in[19] + l * 384, ap->in[20] + l * 384, ap->in[21] + l * 384, ap->in[22] + l * 384, ap->in[9] + l * 384, ap->in[10] + l * 768, ap->in[11] + l * 256};
        float pv_[10];
#pragma unroll
        for (int j = 0; j < 10; ++j) { const int e = tid + 512 * j; float v = 0.f;
            if (e < 4992) { const float* p = (e < 1280) ? src[0] + e : (e < 2048) ? src[1] + (e - 1280) : (e < 2432) ? src[2] + (e - 2048) : (e < 2816) ? src[3] + (e - 2432) : (e < 3200) ? src[4] + (e - 2816)
                                : (e < 3584) ? src[5] + (e - 3200) : (e < 3968) ? src[6] + (e - 3584) : (e < 4736) ? src[7] + (e - 3968) : src[8] + (e - 4736); v = *p; }
            pv_[j] = v; }
#pragma unroll
        for (int j = 0; j < 10; ++j) { const int e = tid + 512 * j; if (e < 4992) PL[e] = pv_[j]; } }
    __syncthreads();
    const LAS float* mu = PL; const LAS float* a0 = PL + 1280; const LAS float* k_a = PL + 2048; const LAS float* r_k = PL + 2432; const LAS float* lnw = PL + 2816; const LAS float* lnb = PL + 3200;
    const LAS float* ga = PL + 3584; const LAS float* cw = PL + 3968; const LAS float* cgn = PL + 4736;
    const u32x4 z4 = (u32x4){0u, 0u, 0u, 0u}; const u32x2 z2 = (u32x2){0u, 0u};
#pragma unroll 1
    for (int tile = gw; tile < NT / 16; tile += NGW) {
        int lane_l = lane; asm volatile("" : "+v"(lane_l));
        const int tk = lane_l & 15, kg = lane_l >> 4;
        const int m = tile * 16 + tk; int T, seqbase, t; seq_of(m, T, seqbase, t); const bool hp = t > 0, hn = t < T - 1;
        const bf16* zr = ZB + (size_t)m * ZW;
        const bf16* zrp = hp ? zr - ZW : (const bf16*)ap->ws; const bf16* zrn = hn ? zr + ZW : (const bf16*)ap->ws;
        bf16* hrow = HB + (size_t)m * DM;
        {
            float ss = 0.f, rs = 0.f;
#pragma unroll 1
            for (int pass = 0; pass < 2; ++pass) {
#pragma unroll 12
                for (int e = 0; e < 12; ++e) { float f[8]; unpack8(*(const u32x4*)(hrow + 32 * e + 8 * kg), f);
                    const f32x4 g0 = *(const LAS f32x4*)(ga + 32 * e + 8 * kg), g1 = *(const LAS f32x4*)(ga + 32 * e + 8 * kg + 4);
#pragma unroll
                    for (int q = 0; q < 8; ++q) ss += f[q] * f[q];
#pragma unroll
                    for (int q = 0; q < 4; ++q) { f[q] *= rs * g0[q]; f[4 + q] *= rs * g1[q]; }
                    if (pass == 1) *(u32x4*)(hrow + 32 * e + 8 * kg) = pack8(f); }
                if (pass == 0) { ss += __shfl_xor(ss, 16); ss += __shfl_xor(ss, 32); rs = rsqrtf(ss * (1.f / 384.f) + 1e-6f); }
            }
        }
        {
            float ss = 0.f;
#pragma unroll 4
            for (int e = 0; e < 8; ++e) { const int c0 = 32 * e + 8 * kg;
                float bg[8], c1[8], h1[8], c0v[8], h0[8], c2[8], h2[8], f[8];
                unpack8(*(const u32x4*)(zr + 1152 + c0), bg); unpack8(*(const u32x4*)(zr + 1408 + c0), c1); unpack8(*(const u32x4*)(zr + 1664 + c0), h1);
                unpack8(*(const u32x4*)(zrp + 1408 + c0), c0v); unpack8(*(const u32x4*)(zrp + 1664 + c0), h0);
                unpack8(*(const u32x4*)(zrn + 1408 + c0), c2); unpack8(*(const u32x4*)(zrn + 1664 + c0), h2);
#pragma unroll
                for (int q = 0; q < 8; ++q) f[q] = bg[q] * (c0v[q] * h0[q] * cw[c0 + q] + c1[q] * h1[q] * cw[256 + c0 + q] + c2[q] * h2[q] * cw[512 + c0 + q]);
                const u32x4 w = pack8(f); float g[8]; unpack8(w, g);
#pragma unroll
                for (int q = 0; q < 8; ++q) ss += g[q] * g[q];
                *(u32x4*)(hrow + 384 + c0) = w; }
            ss += __shfl_xor(ss, 16); ss += __shfl_xor(ss, 32); const float rs = rsqrtf(ss * (1.f / 256.f) + 1e-6f);
#pragma unroll 8
            for (int e = 0; e < 8; ++e) { const int c0 = 32 * e + 8 * kg; float f[8]; unpack8(*(const u32x4*)(hrow + 384 + c0), f);
#pragma unroll
                for (int q = 0; q < 8; ++q) f[q] *= rs * cgn[c0 + q];
                *(u32x4*)(hrow + 384 + c0) = pack8(f); }
        }
        bf16x8 Bad, Bg0, Bg1;
        {   const int ca = 3104 + 8 * kg; float fc[8], fp[8], fn[8], x[8];
            unpack8(*(const u32x4*)(zr + ca), fc); unpack8(*(const u32x4*)(zrp + ca), fp); unpack8(*(const u32x4*)(zrn + ca), fn);
#pragma unroll
            for (int q = 0; q < 8; ++q) x[q] = fc[q] + (0.5f * (fp[q] + fn[q]) - fc[q]) * mu[1184 + 8 * kg + q];
            Bad = __builtin_bit_cast(bf16x8, pack8(x));
#pragma unroll
            for (int ks = 0; ks < 2; ++ks) { const int cg2 = 3136 + 32 * ks + 8 * kg;
                unpack8(*(const u32x4*)(zr + cg2), fc); unpack8(*(const u32x4*)(zrp + cg2), fp); unpack8(*(const u32x4*)(zrn + cg2), fn);
#pragma unroll
                for (int q = 0; q < 8; ++q) x[q] = sigm(fc[q] + (0.5f * (fp[q] + fn[q]) - fc[q]) * mu[1216 + 32 * ks + 8 * kg + q]);
                if (ks == 0) Bg0 = __builtin_bit_cast(bf16x8, pack8(x)); else Bg1 = __builtin_bit_cast(bf16x8, pack8(x)); }
        }
#pragma unroll 1
        for (int h = 0; h < 6; ++h) {
            float bsum = 0.f, ysum = 0.f, ysq = 0.f;
            const f32x4 zf = (f32x4){0.f, 0.f, 0.f, 0.f};
            const bf16* ybA = (const bf16*)YB + (size_t)m * 384; const bf16* ybB = ybA + (size_t)NT * 384;
            u32x4 Lr[2][3], Lk[2][3], Lv[2][3], Ly[2][2];
#pragma unroll
            for (int p2 = 0; p2 < 2; ++p2) { const int c8 = h * 64 + 32 * p2 + 8 * kg;
                Lr[p2][0] = *(const u32x4*)(zr + 1920 + c8); Lr[p2][1] = *(const u32x4*)(zrp + 1920 + c8); Lr[p2][2] = *(const u32x4*)(zrn + 1920 + c8);
                Lk[p2][0] = *(const u32x4*)(zr + 2304 + c8); Lk[p2][1] = *(const u32x4*)(zrp + 2304 + c8); Lk[p2][2] = *(const u32x4*)(zrn + 2304 + c8);
                Lv[p2][0] = *(const u32x4*)(zr + 2688 + c8); Lv[p2][1] = *(const u32x4*)(zrp + 2688 + c8); Lv[p2][2] = *(const u32x4*)(zrn + 2688 + c8);
                Ly[p2][0] = *(const u32x4*)(ybA + c8); Ly[p2][1] = *(const u32x4*)(ybB + c8); }
#pragma unroll
            for (int p2 = 0; p2 < 2; ++p2) {
                const int cbase = h * 64 + 32 * p2, c8 = cbase + 8 * kg, rowA = cbase + 8 * (tk >> 2) + (tk & 3), rowB = rowA + 4;
                const bf16x8 Wa0A = *(const LAS bf16x8*)(AUPT + rowA * 40 + 8 * kg), Wa0B = *(const LAS bf16x8*)(AUPT + rowB * 40 + 8 * kg);
                const bf16x8 Wa1A = *(const LAS bf16x8*)(AUPT + (384 + rowA) * 40 + 8 * kg), Wa1B = *(const LAS bf16x8*)(AUPT + (384 + rowB) * 40 + 8 * kg);
                const f32x4 A0a = __builtin_amdgcn_mfma_f32_16x16x32_bf16(Wa0A, Bad, zf, 0, 0, 0), A0b = __builtin_amdgcn_mfma_f32_16x16x32_bf16(Wa0B, Bad, zf, 0, 0, 0);
                const f32x4 A1a = __builtin_amdgcn_mfma_f32_16x16x32_bf16(Wa1A, Bad, zf, 0, 0, 0), A1b = __builtin_amdgcn_mfma_f32_16x16x32_bf16(Wa1B, Bad, zf, 0, 0, 0);
                float rc[8], rp[8], rn[8], kc[8], kp[8], kn[8], ya[8], yb2[8];
                unpack8(Lr[p2][0], rc); unpack8(Lr[p2][1], rp); unpack8(Lr[p2][2], rn);
                unpack8(Lk[p2][0], kc); unpack8(Lk[p2][1], kp); unpack8(Lk[p2][2], kn);
                unpack8(Ly[p2][0], ya); unpack8(Ly[p2][1], yb2);
#pragma unroll
                for (int i = 0; i < 8; ++i) {
                    const float s0 = (i < 4) ? A0a[i & 3] : A0b[i & 3], s1 = (i < 4) ? A1a[i & 3] : A1b[i & 3];
                    const float rr = rc[i] + (0.5f * (rp[i] + rn[i]) - rc[i]) * mu[c8 + i], kk = kc[i] + (0.5f * (kp[i] + kn[i]) - kc[i]) * mu[384 + c8 + i];
                    const float av0 = sigm(s0 + a0[c8 + i]), av1 = sigm(s1 + a0[384 + c8 + i]); const float ka = k_a[c8 + i];
                    const float kd = kk * ((1.f + (av0 - 1.f) * ka) + (1.f + (av1 - 1.f) * ka));
                    const float y = ya[i] + yb2[i];
                    bsum += rr * kd * r_k[c8 + i]; ysum += y; ysq += y * y;
                }
            }
            bsum += __shfl_xor(bsum, 16); bsum += __shfl_xor(bsum, 32); ysum += __shfl_xor(ysum, 16); ysum += __shfl_xor(ysum, 32); ysq += __shfl_xor(ysq, 16); ysq += __shfl_xor(ysq, 32);
            const float mean = ysum * (1.f / 64.f); const float var = fmaxf(ysq * (1.f / 64.f) - mean * mean, 0.f);
            const float rstd = rsqrtf(var + 64e-5f);
#pragma unroll
            for (int p2 = 0; p2 < 2; ++p2) {
                const int cbase = h * 64 + 32 * p2, c8 = cbase + 8 * kg, rowA = cbase + 8 * (tk >> 2) + (tk & 3), rowB = rowA + 4;
                const bf16x8 Wg0A = *(const LAS bf16x8*)(GUPT + rowA * 72 + 8 * kg), Wg1A = *(const LAS bf16x8*)(GUPT + rowA * 72 + 32 + 8 * kg);
                const bf16x8 Wg0B = *(const LAS bf16x8*)(GUPT + rowB * 72 + 8 * kg), Wg1B = *(const LAS bf16x8*)(GUPT + rowB * 72 + 32 + 8 * kg);
                f32x4 Ga = __builtin_amdgcn_mfma_f32_16x16x32_bf16(Wg0A, Bg0, zf, 0, 0, 0); Ga = __builtin_amdgcn_mfma_f32_16x16x32_bf16(Wg1A, Bg1, Ga, 0, 0, 0);
                f32x4 Gb = __builtin_amdgcn_mfma_f32_16x16x32_bf16(Wg0B, Bg0, zf, 0, 0, 0); Gb = __builtin_amdgcn_mfma_f32_16x16x32_bf16(Wg1B, Bg1, Gb, 0, 0, 0);
                float vc[8], vp[8], vn[8], ya[8], yb2[8], o[8];
                unpack8(Lv[p2][0], vc); unpack8(Lv[p2][1], vp); unpack8(Lv[p2][2], vn);
                unpack8(Ly[p2][0], ya); unpack8(Ly[p2][1], yb2);
#pragma unroll
                for (int i = 0; i < 8; ++i) { const float v = vc[i] + (0.5f * (vp[i] + vn[i]) - vc[i]) * mu[768 + c8 + i]; const float g = (i < 4) ? Ga[i & 3] : Gb[i & 3];
                    o[i] = (((ya[i] + yb2[i]) - mean) * rstd * lnw[c8 + i] + lnb[c8 + i] + bsum * v) * g; }
                *(u32x4*)(hrow + 640 + c8) = pack8(o);
            }
        }
    }
}

#define XB_TMO      128
#define XB_XCNT(j)  (256  + 64 * (j))
#define XB_XSUB(j)  (1280 + 64 * (j))
#define XB_XGEN(j)  (2304 + 64 * (j))
#define XB_TOP      3328
#define XB_TOPGEN   3392
#define XCD_BAR_WORDS 3456
#define XB_SPIN_CAP (1u << 18)

__device__ __forceinline__ unsigned xb_ld(unsigned* p)              { return __hip_atomic_load(p, __ATOMIC_RELAXED, __HIP_MEMORY_SCOPE_AGENT); }
__device__ __forceinline__ unsigned xb_add(unsigned* p, unsigned v) { return __hip_atomic_fetch_add(p, v, __ATOMIC_RELAXED, __HIP_MEMORY_SCOPE_AGENT); }
__device__ __forceinline__ unsigned xb_xcc_id() { return (unsigned)__builtin_amdgcn_s_getreg((3 << 11) | 20) & 0xFu; }
#define XB_SPIN(cond, bar) do { unsigned _sp = 0; while (cond) { __builtin_amdgcn_s_sleep(1); \
    if ((++_sp & 255u) == 0u) { if (xb_ld(&(bar)[XB_TMO])) break; if (_sp > XB_SPIN_CAP) { atomicAdd(&(bar)[XB_TMO], 1u); break; } } } } while (0)

struct XcdBarrier {
    unsigned* bar; unsigned x;
    volatile LAS unsigned* st;
};

__device__ __forceinline__ XcdBarrier xcd_barrier_post(unsigned* bar, volatile LAS unsigned* st) {
    XcdBarrier b; b.bar = bar; b.x = xb_xcc_id(); b.st = st;
    if (threadIdx.x == 0) (void)xb_add(&bar[XB_XCNT(b.x)], 1u);
    return b;
}
__device__ __forceinline__ void xcd_barrier_complete(unsigned* bar, unsigned x, unsigned& nloc, unsigned& nx) {
    const unsigned G = gridDim.x * gridDim.y * gridDim.z;
    unsigned sum, cnt, mine, sp = 0u;
    for (;;) {
        sum = 0u; cnt = 0u; mine = 0u;
#pragma unroll
        for (unsigned j = 0; j < 16; ++j) { const unsigned c = xb_ld(&bar[XB_XCNT(j)]); sum += c; cnt += (c > 0u) ? 1u : 0u; mine = (j == x) ? c : mine; }
        if (sum == G) break;
        __builtin_amdgcn_s_sleep(1);
        if ((++sp & 255u) == 0u) { if (xb_ld(&bar[XB_TMO])) break; if (sp > XB_SPIN_CAP) { atomicAdd(&bar[XB_TMO], 1u); break; } }
    }
    nloc = mine > 0u ? mine : 1u; nx = cnt > 0u ? cnt : 1u;
}

__device__ __forceinline__ void xcd_barrier(const XcdBarrier& b) {
    asm volatile("s_waitcnt vmcnt(0)" ::: "memory");
    __syncthreads();
    if (threadIdx.x == 0) {
        unsigned* bar = b.bar;
        __builtin_amdgcn_s_waitcnt(0);
        unsigned nloc = b.st[0], nx = b.st[1];
        if (nloc == 0u) { xcd_barrier_complete(bar, b.x, nloc, nx); b.st[0] = nloc; b.st[1] = nx; }
        const unsigned old = xb_add(&bar[XB_XSUB(b.x)], 1u);
        const unsigned gen = old / nloc;
        if (old + 1u == (gen + 1u) * nloc) {
            __builtin_amdgcn_fence(__ATOMIC_RELEASE, "agent");
            asm volatile("s_waitcnt vmcnt(0)" ::: "memory");
            const unsigned og = xb_add(&bar[XB_TOP], 1u);
            const unsigned tg = og / nx;
            if (og + 1u == (tg + 1u) * nx) xb_add(&bar[XB_TOPGEN], 1u);
            else XB_SPIN(xb_ld(&bar[XB_TOPGEN]) == tg, bar);
            __builtin_amdgcn_fence(__ATOMIC_ACQUIRE, "agent");
            xb_add(&bar[XB_XGEN(b.x)], 1u);
            asm volatile("s_waitcnt vmcnt(0)" ::: "memory");
        } else {
            XB_SPIN(xb_ld(&bar[XB_XGEN(b.x)]) == gen, bar);
            __builtin_amdgcn_fence(__ATOMIC_ACQUIRE, "agent");
            asm volatile("s_waitcnt vmcnt(0)" ::: "memory");
        }
    }
    __syncthreads();
}

#define WSP(off) (ap->ws + (off))
#ifndef PROBE_MASK
#define PROBE_MASK 0
#endif
#define PH_BEGIN(id) unsigned long long t0_ = 0; if (PROBE_MASK & (1 << (id))) t0_ = __builtin_amdgcn_s_memrealtime()
#define PH_END(id) do { if (PROBE_MASK & (1 << (id))) { const unsigned long long t1_ = __builtin_amdgcn_s_memrealtime(); const unsigned long long dt_ = t1_ - t0_; \
    while (__builtin_amdgcn_s_memrealtime() - t1_ < dt_) __builtin_amdgcn_s_sleep(8); grid.sync(); } } while (0)
__global__ void __launch_bounds__(512, 2) mega_fwd(Args a_unused) {
    extern __shared__ __attribute__((aligned(16))) unsigned char lds_raw[];
    LAS unsigned char* lds = (LAS unsigned char*)lds_raw;
    cg::grid_group grid = cg::this_grid();
    {   volatile LAS unsigned* st_ = (volatile LAS unsigned*)(lds + LDS_BYTES - 48);
        if (threadIdx.x < 2) st_[threadIdx.x] = 0u;
        __syncthreads();
        CArgs* ap = KARGS(); (void)xcd_barrier_post((unsigned*)(ap->ws + 16384u), st_); }
#define GSYNC() do { CArgs* apb_ = KARGS(); XcdBarrier b_; b_.bar = (unsigned*)(apb_->ws + 16384u); b_.x = xb_xcc_id(); b_.st = (volatile LAS unsigned*)(lds + LDS_BYTES - 48); xcd_barrier(b_); } while (0)
#define IDS() int tid_l_ = threadIdx.x; asm volatile("" : "+v"(tid_l_)); const int tid = tid_l_, lane = tid & 63, wave = __builtin_amdgcn_readfirstlane(tid >> 6); const int G = gridDim.x, gw = blockIdx.x * 8 + wave, NGW = G * 8; (void)tid; (void)lane; (void)gw; (void)NGW; (void)G
#ifdef ONLY_FINAL
    {   IDS(); CArgs* ap = KARGS(); const int l = 0;
        phase_final(lds, (const bf16*)WSP(WS_ZB), (const float*)WSP(WS_YB), (bf16*)WSP(WS_HB), ap, l, gw, NGW, tid, lane, wave); }
    return;
#endif
#ifdef ONLY_MIX
    {   IDS(); CArgs* ap = KARGS(); const int l = 0;
        phase_mixers(lds, (const bf16*)WSP(WS_ZB), (float*)WSP(WS_YB), (bf16*)WSP(WS_HB), ap, l, (unsigned*)WSP(CNT_OFF) + 64 * l, tid, lane, wave); }
    return;
#endif
    { PH_BEGIN(0);
    {   IDS(); CArgs* ap = KARGS();
        phase_prologue(lds, ap, gw, NGW, lane, wave);
        phase_norm0(ap->in[0], ap->in[1], ap->in[3], (bf16*)WSP(WS_HB), gw, NGW, lane); }
    grid.sync(); PH_END(0); }
#pragma unroll 1
    for (int l = 0; l < 2; ++l) {
        { PH_BEGIN(1);
        {   IDS(); CArgs* ap = KARGS();
            pg8::Gemm g{(bf16*)WSP(WS_HB), (bf16*)WSP(WS_WIN) + (size_t)l * ZWP * DM, NT, ZWP, DM}; pg8::StaticOrder S; S.init(NT, ZWP, G, (int)blockIdx.x);
            pg8::EpiMy<0> E{(bf16*)WSP(WS_ZB), ZW, ZW, nullptr};
            pg8::gemm_phase<pg8::EpiMy<0>, pg8::StaticOrder, true, true>(lds, g, S, E); }
        GSYNC(); PH_END(1); }
        { PH_BEGIN(2);
        {   IDS(); CArgs* ap = KARGS();
#ifndef NO_MIX
            phase_mixers(lds, (const bf16*)WSP(WS_ZB), (float*)WSP(WS_YB), (bf16*)WSP(WS_HB), ap, l, (unsigned*)WSP(CNT_OFF) + 64 * l, tid, lane, wave);
#endif
        }
        GSYNC(); PH_END(2); }
        { PH_BEGIN(3);
        {   IDS(); CArgs* ap = KARGS();
#ifndef NO_FINAL
            phase_final(lds, (const bf16*)WSP(WS_ZB), (const float*)WSP(WS_YB), (bf16*)WSP(WS_HB), ap, l, gw, NGW, tid, lane, wave);
#endif
        }
        GSYNC(); PH_END(3); }
        { PH_BEGIN(4);
        {   IDS(); CArgs* ap = KARGS();
            pg8::Gemm g{(bf16*)WSP(WS_HB), (bf16*)WSP(WS_WOUT) + (size_t)l * DM * DM, NT, DM, DM}; pg8::StaticOrder S; S.init(NT, DM, G, (int)blockIdx.x);
            pg8::EpiMy<0> E{(bf16*)WSP(WS_RAW), DM, DM, nullptr};
            pg8::gemm_phase<pg8::EpiMy<0>, pg8::StaticOrder, true, true>(lds, g, S, E); }
        GSYNC(); PH_END(4); }
        { PH_BEGIN(5);
        {   IDS(); CArgs* ap = KARGS();
            phase_resid(ap->in[0], ap->in[1], l == 0, ap->out, (const bf16*)WSP(WS_RAW), ap->in[4] + l * DM, ap->in[5] + l * DM, (bf16*)WSP(WS_HB), gw, NGW, lane); }
        GSYNC(); PH_END(5); }
        { PH_BEGIN(6);
        {   IDS(); CArgs* ap = KARGS();
            pg8::Gemm g{(bf16*)WSP(WS_HB), (bf16*)WSP(WS_W1) + (size_t)l * FFD * DM, NT, FFD, DM}; pg8::StaticOrder S; S.init(NT, FFD, G, (int)blockIdx.x);
            pg8::EpiMy<1> E{(bf16*)WSP(WS_HID), FFD, FFD, nullptr};
            pg8::gemm_phase<pg8::EpiMy<1>, pg8::StaticOrder, true, true>(lds, g, S, E); }
        GSYNC(); PH_END(6); }
        { PH_BEGIN(7);
        {   IDS(); CArgs* ap = KARGS();
            pg8::Gemm g{(bf16*)WSP(WS_HID), (bf16*)WSP(WS_W2) + (size_t)l * DM * FFD, NT, DM, FFD}; pg8::StaticOrder S; S.init(NT, DM, G, (int)blockIdx.x);
            pg8::EpiMy<0> E{(bf16*)WSP(WS_HB), DM, DM, nullptr};
            pg8::gemm_phase<pg8::EpiMy<0>, pg8::StaticOrder, true, true>(lds, g, S, E); }
        GSYNC(); PH_END(7); }
        { PH_BEGIN(8);
        {   IDS(); CArgs* ap = KARGS();
            phase_resid(ap->in[0], ap->in[1], false, ap->out, (const bf16*)WSP(WS_HB), ap->in[6] + l * DM, (l == 0) ? ap->in[3] + DM : nullptr, (bf16*)WSP(WS_HB), gw, NGW, lane); }
        if (l == 0) GSYNC();
        PH_END(8); }
    }
}

extern "C" void kernel_launch(void* const* d_in, const int* in_sizes, int n_in, void* d_out, int out_size, void* d_ws, size_t ws_size, hipStream_t stream) {
    static int grid = 0;
    if (grid == 0) {
        if (n_in != 25 || out_size != NT * DM || ws_size < WS_END) { fprintf(stderr, "kernel_launch: unexpected shapes (n_in %d, out %d, ws %zu)\n", n_in, out_size, ws_size); grid = -1; return; }
        int dev = 0, cus = 0, per_cu = 0;
        if (hipGetDevice(&dev) != hipSuccess || hipDeviceGetAttribute(&cus, hipDeviceAttributeMultiprocessorCount, dev) != hipSuccess) { grid = -1; return; }
        if (hipFuncSetAttribute((const void*)mega_fwd, hipFuncAttributeMaxDynamicSharedMemorySize, LDS_BYTES) != hipSuccess) { fprintf(stderr, "kernel_launch: hipFuncSetAttribute failed\n"); grid = -1; return; }
        if (hipOccupancyMaxActiveBlocksPerMultiprocessor(&per_cu, (const void*)mega_fwd, 512, LDS_BYTES) != hipSuccess || per_cu < 1) { fprintf(stderr, "kernel_launch: occupancy query says %d\n", per_cu); per_cu = 1; }
        (void)hipGetLastError();
        grid = cus;
    }
    if (grid < 0) return;
    (void)hipMemsetAsync(d_ws, 0, WS_CTLB, stream);
    Args a{};
    for (int i = 0; i < 25; ++i) a.in[i] = (const float*)d_in[i];
    a.out = (float*)d_out; a.ws = (unsigned char*)d_ws;
    void* args[] = {&a};
    const hipError_t e = hipLaunchCooperativeKernel((const void*)mega_fwd, dim3(grid), dim3(512), args, LDS_BYTES, stream);
    if (e != hipSuccess) fprintf(stderr, "kernel_launch: cooperative launch failed: %s (grid %d)\n", hipGetErrorString(e), grid);
}
```

```cpp
#include <hip/hip_runtime.h>
#include <hip/hip_cooperative_groups.h>
#include <cstdio>
#include <cstdint>
namespace pg8 {
#define PG8_LAS __attribute__((address_space(3)))
typedef unsigned short bf16_t;
typedef short bf16x8 __attribute__((ext_vector_type(8)));
typedef float f32x4 __attribute__((ext_vector_type(4)));
typedef unsigned u32x4 __attribute__((ext_vector_type(4)));
constexpr int BM = 256, BK = 64, HALF = 128, HTB = HALF * BK * 2  , STAGE_BYTES = 8 * HTB, NXCD = 8, WGM = 8;

__host__ __device__ __forceinline__ int lds_byte(int r, int c) { const int st = (r >> 4) * 2 + (c >> 5), rr = r & 15, cc = c & 31, ob = rr * 64 + cc * 2; return st * 1024 + (ob ^ (((ob >> 9) & 1) << 5)); }
__host__ __device__ __forceinline__ void stage_rc(int b, int& R, int& C) { const int st = b / 1024, sb = b % 1024, swz = sb ^ (((sb >> 9) & 1) << 5); R = (st >> 1) * 16 + swz / 64; C = (st & 1) * 32 + (swz % 64) / 2; }
__host__ __device__ __forceinline__ int perm32(int rho) { const int n = rho >> 4, i = rho & 15; return 8 * (i >> 2) + 4 * n + (i & 3); }

struct Unit { int pm, pn; };
struct Gemm { const bf16_t* A; const bf16_t* Bt; int M, N, K; };

struct StaticOrder {
    int nM, nN, nwg, G, c;
    __host__ __device__ void init(int M, int N, int G_, int c_) { nM = M / BM; nN = N / BM; nwg = nM * nN; G = G_; c = c_; }
    __host__ __device__ bool next(int i, Unit& u) const {
        const long L = (long)i * G + c; if (L >= nwg) return false;
        int wgid = (int)L; { const int q = nwg / NXCD, r = nwg % NXCD, xcd = wgid % NXCD, off = wgid / NXCD; wgid = (xcd < r ? xcd * (q + 1) : r * (q + 1) + (xcd - r) * q) + off; }
        const int nig = WGM * nN, gid = wgid / nig, fm = gid * WGM, gsz = (nM - fm) < WGM ? (nM - fm) : WGM;
        u.pm = fm + ((wgid % nig) % gsz); u.pn = (wgid % nig) / gsz; return true;
    }
    __device__ __forceinline__ void a_ready(const Unit&) const {}
    __device__ __forceinline__ void done(const Unit&) const {}
};

__device__ __forceinline__ unsigned cvt_pk_bf16(float lo, float hi) { unsigned r; asm volatile("v_cvt_pk_bf16_f32 %0, %1, %2" : "=v"(r) : "v"(lo), "v"(hi)); return r; }
typedef float f32x2 __attribute__((ext_vector_type(2)));
__device__ __forceinline__ f32x2 gelu_pk(f32x2 v) {
    const f32x2 av = __builtin_elementwise_abs(v), d = av * 0.2316418882f + 1.0f;
    f32x2 t; t.x = __builtin_amdgcn_rcpf(d.x); t.y = __builtin_amdgcn_rcpf(d.y);
    f32x2 q = t * 0.5307027145f + (-0.7265760135f); q = q * t + 0.7107068705f; q = q * t + (-0.142248368f); q = q * t + 0.127414796f; q = q * t;
    const f32x2 s = (v * v) * (-0.72134752044f);
    f32x2 e; e.x = __builtin_amdgcn_exp2f(s.x); e.y = __builtin_amdgcn_exp2f(s.y);
    const f32x2 m = v * (q * e), r = v - m;
    f32x2 o; o.x = v.x < 0.f ? m.x : r.x; o.y = v.y < 0.f ? m.y : r.y; return o;
}

template <int ACT  > struct EpiBf16 {
    static constexpr bool PERM = true, AFTER_DRAIN = false; static_assert(ACT == 0 || ACT == 1, "EpiBf16: ACT is 0 (none) or 1 (gelu_pk)");
    bf16_t* O; int ldc; const float* bias; int split_cols; size_t split_stride; float scale0;
    __device__ __forceinline__ void operator()(const f32x4 (&acc)[2][2][4][2], const Unit& u, int wr, int wc, int fr, int fq) const {
        const int row0 = u.pm * BM + wr * 64 + fr; int colt = u.pn * BM; bf16_t* base = O;
        float sc = 1.f; if (split_cols) { const int t = colt / split_cols; base += (size_t)t * split_stride; colt -= t * split_cols; if (t == 0) sc = scale0; }
        const int col0 = colt + wc * 32 + 8 * fq, bcol0 = u.pn * BM + wc * 32 + 8 * fq;
        f32x4 bv[2][2];
#pragma unroll
        for (int bj = 0; bj < 2; ++bj)
#pragma unroll
            for (int n = 0; n < 2; ++n) bv[bj][n] = bias ? *(const f32x4*)(bias + bcol0 + bj * HALF + 4 * n) : (f32x4){0.f, 0.f, 0.f, 0.f};
#pragma unroll
        for (int ai = 0; ai < 2; ++ai)
#pragma unroll
            for (int m = 0; m < 4; ++m) { bf16_t* rowp = base + (size_t)(row0 + ai * HALF + m * 16) * ldc + col0;
#pragma unroll
                for (int bj = 0; bj < 2; ++bj) { f32x4 v0 = acc[ai][bj][m][0] + bv[bj][0], v1 = acc[ai][bj][m][1] + bv[bj][1];
                    if (ACT == 1) { f32x2 a = gelu_pk((f32x2){v0[0], v0[1]}), b = gelu_pk((f32x2){v0[2], v0[3]}), c = gelu_pk((f32x2){v1[0], v1[1]}), d = gelu_pk((f32x2){v1[2], v1[3]});
                        v0 = (f32x4){a.x, a.y, b.x, b.y}; v1 = (f32x4){c.x, c.y, d.x, d.y}; }
                    v0 = v0 * sc; v1 = v1 * sc; u32x4 w; w.x = cvt_pk_bf16(v0[0], v0[1]); w.y = cvt_pk_bf16(v0[2], v0[3]); w.z = cvt_pk_bf16(v1[0], v1[1]); w.w = cvt_pk_bf16(v1[2], v1[3]);
                    *(u32x4*)(rowp + bj * HALF) = w; } }
    }
};

template <int MODE> struct EpiMy {
    static constexpr bool PERM = true, AFTER_DRAIN = false;
    bf16_t* O; int ldc; int ncv; float* ssq;
    __device__ __forceinline__ void operator()(const f32x4 (&acc)[2][2][4][2], const Unit& u, int wr, int wc, int fr, int fq) const {
        const int row0 = u.pm * BM + wr * 64 + fr; const int col0 = u.pn * BM + wc * 32 + 8 * fq;
#pragma unroll
        for (int ai = 0; ai < 2; ++ai)
#pragma unroll
            for (int m = 0; m < 4; ++m) {
                const int row = row0 + ai * HALF + m * 16;
                bf16_t* rowp = O + (size_t)row * ldc + col0;
                float ss = 0.f;
#pragma unroll
                for (int bj = 0; bj < 2; ++bj) {
                    f32x4 v0 = acc[ai][bj][m][0], v1 = acc[ai][bj][m][1];
                    if (MODE == 1) {
#pragma unroll
                        for (int e = 0; e < 4; ++e) { const float a0 = fmaxf(v0[e], 0.f), a1 = fmaxf(v1[e], 0.f); v0[e] = a0 * a0; v1[e] = a1 * a1; }
                    }
                    if (MODE == 2) ss += (v0[0] * v0[0] + v0[1] * v0[1]) + (v0[2] * v0[2] + v0[3] * v0[3]) + (v1[0] * v1[0] + v1[1] * v1[1]) + (v1[2] * v1[2] + v1[3] * v1[3]);
                    u32x4 w; w.x = cvt_pk_bf16(v0[0], v0[1]); w.y = cvt_pk_bf16(v0[2], v0[3]); w.z = cvt_pk_bf16(v1[0], v1[1]); w.w = cvt_pk_bf16(v1[2], v1[3]);
                    if (col0 + bj * HALF < ncv) *(u32x4*)(rowp + bj * HALF) = w;
                }
                if (MODE == 2) { ss += __shfl_xor(ss, 16); ss += __shfl_xor(ss, 32); if (fq == 0) unsafeAtomicAdd(ssq + row, ss); }
            }
    }
};
template <class Epi, class Sched, bool ALIGN_EPI = false, bool SP2 = false>
__device__ __forceinline__ void gemm_phase(PG8_LAS unsigned char* lds, const Gemm g, const Sched& S, const Epi& E) {
    int tid_l_ = threadIdx.x; asm volatile("" : "+v"(tid_l_)); const int tid = tid_l_, wid = __builtin_amdgcn_readfirstlane(tid >> 6), lane = tid & 63, wr = wid >> 2, wc = wid & 3, fr = lane & 15, fq = lane >> 4;
    int Kl_ = g.K; asm volatile("" : "+s"(Kl_)); const int K = Kl_, nt = K / BK;
    unsigned voffA[2], voffB[2];
#pragma unroll
    for (int i = 0; i < 2; ++i) { int R, C; stage_rc(tid * 16 + i * 8192, R, C); const int Rb = Epi::PERM ? ((R & ~31) + perm32(R & 31)) : R;
        voffA[i] = (unsigned)(R * K + C) * 2u; voffB[i] = (unsigned)(Rb * K + C) * 2u; }
    const size_t kstep = (size_t)(BK * 2);
    const size_t hstep = (size_t)HALF * K * 2;
    const size_t tstep = 2 * hstep;
    const unsigned ldsw = (unsigned)wid * 1024u;
    const int aoff = lds_byte(wr * 64 + fr, fq * 8), boff = lds_byte(wc * 32 + fr, fq * 8);
#define PG8_SA(b, h) (((b) * 2 + (h)) * HTB)
#define PG8_SB(b, h) ((4 + (b) * 2 + (h)) * HTB)
#define PG8_STAGE(bufoff, gbase, voff) do { _Pragma("unroll") for (int _i = 0; _i < 2; ++_i) \
        __builtin_amdgcn_global_load_lds((const unsigned*)((const char*)(gbase) + (voff)[_i]), (PG8_LAS unsigned*)(lds + (bufoff) + ldsw + _i * 8192), 16, 0, 0); } while (0)
#define PG8_LDA(dst, b, h) do { _Pragma("unroll") for (int m = 0; m < 4; ++m) _Pragma("unroll") for (int k = 0; k < 2; ++k) dst[m][k] = *(const PG8_LAS bf16x8*)(lds + PG8_SA(b, h) + aoff + m * 2048 + k * 1024); } while (0)
#define PG8_LDB(dst, b, h) do { _Pragma("unroll") for (int n = 0; n < 2; ++n) _Pragma("unroll") for (int k = 0; k < 2; ++k) dst[n][k] = *(const PG8_LAS bf16x8*)(lds + PG8_SB(b, h) + boff + n * 2048 + k * 1024); } while (0)
#define PG8_MMA(ai, bj, At, Bt) do { __builtin_amdgcn_s_setprio(1); _Pragma("unroll") for (int m = 0; m < 4; ++m) _Pragma("unroll") for (int n = 0; n < 2; ++n) _Pragma("unroll") for (int k = 0; k < 2; ++k) \
        acc[ai][bj][m][n] = __builtin_amdgcn_mfma_f32_16x16x32_bf16(Bt[n][k], At[m][k], acc[ai][bj][m][n], 0, 0, 0); __builtin_amdgcn_s_setprio(0); } while (0)
#define PG8_WAIT_V(n) asm volatile("s_waitcnt vmcnt(" #n ")" ::: "memory")
#define PG8_WAIT_L(n) asm volatile("s_waitcnt lgkmcnt(" #n ")" ::: "memory")
#define PG8_BAR __builtin_amdgcn_s_barrier()
#define PG8_SCHED __builtin_amdgcn_sched_barrier(0)
    Unit cur, nxt; int ui = 0;
    if (!S.next(0, cur)) return;
    f32x4 acc[2][2][4][2];
#pragma unroll
    for (int a = 0; a < 2; ++a)
#pragma unroll
        for (int b = 0; b < 2; ++b)
#pragma unroll
            for (int m = 0; m < 4; ++m)
#pragma unroll
                for (int n = 0; n < 2; ++n) acc[a][b][m][n] = (f32x4){0.f, 0.f, 0.f, 0.f};
    bf16x8 At[4][2], B0[2][2], B1[2][2];
    const char* cA = (const char*)g.A + (size_t)cur.pm * tstep; const char* cB = (const char*)g.Bt + (size_t)cur.pn * tstep;
    S.a_ready(cur);
    if constexpr (SP2) {
        PG8_STAGE(PG8_SB(0, 0), cB, voffB); PG8_STAGE(PG8_SB(0, 1), cB + hstep, voffB); PG8_STAGE(PG8_SA(0, 0), cA, voffA); PG8_STAGE(PG8_SA(0, 1), cA + hstep, voffA);
        if (wr == 1) PG8_BAR;
        PG8_WAIT_V(2); PG8_BAR;
        PG8_STAGE(PG8_SB(1, 0), cB + kstep, voffB); PG8_STAGE(PG8_SA(1, 0), cA + kstep, voffA); PG8_STAGE(PG8_SB(1, 1), cB + hstep + kstep, voffB);
        PG8_WAIT_V(6); PG8_BAR;
    } else {
        PG8_STAGE(PG8_SB(0, 0), cB, voffB); PG8_STAGE(PG8_SA(0, 0), cA, voffA); PG8_STAGE(PG8_SB(0, 1), cB + hstep, voffB); PG8_STAGE(PG8_SA(0, 1), cA + hstep, voffA);
        if (wr == 1) PG8_BAR;
        PG8_WAIT_V(4); PG8_BAR;
        PG8_STAGE(PG8_SB(1, 0), cB + kstep, voffB); PG8_STAGE(PG8_SA(1, 0), cA + kstep, voffA); PG8_STAGE(PG8_SB(1, 1), cB + hstep + kstep, voffB);
        PG8_WAIT_V(6); PG8_BAR;
    }
    for (;;) {
        const bool has_next = S.next(ui + 1, nxt);
        const char* nA = has_next ? (const char*)g.A + (size_t)nxt.pm * tstep : cA; const char* nB = has_next ? (const char*)g.Bt + (size_t)nxt.pn * tstep : cB;
        for (int t = 0; t < nt; t += 2) {
            const bool last = (t == nt - 2);
            const char* a1 = cA + (size_t)(t + 1) * kstep;
            const char* a2 = last ? nA : cA + (size_t)(t + 2) * kstep; const char* b2 = last ? nB : cB + (size_t)(t + 2) * kstep;
            const char* a3 = a2 + kstep; const char* b3 = b2 + kstep;
            if (last && has_next) S.a_ready(nxt);
            if constexpr (SP2) {
            PG8_LDB(B0, 0, 0); PG8_LDB(B1, 0, 1); PG8_SCHED; PG8_LDA(At, 0, 0); PG8_STAGE(PG8_SA(1, 1), a1 + hstep, voffA);
            PG8_WAIT_V(8); PG8_WAIT_L(0); PG8_BAR; PG8_MMA(0, 0, At, B0); PG8_MMA(0, 1, At, B1); PG8_BAR; PG8_SCHED;
            PG8_LDA(At, 0, 1); PG8_STAGE(PG8_SB(0, 0), b2, voffB); PG8_STAGE(PG8_SB(0, 1), b2 + hstep, voffB); PG8_STAGE(PG8_SA(0, 0), a2, voffA);
            PG8_WAIT_V(8); PG8_WAIT_L(0); PG8_BAR; PG8_MMA(1, 0, At, B0); PG8_MMA(1, 1, At, B1); PG8_BAR; PG8_SCHED;
            PG8_LDB(B0, 1, 0); PG8_LDB(B1, 1, 1); PG8_SCHED; PG8_LDA(At, 1, 0); PG8_STAGE(PG8_SA(0, 1), a2 + hstep, voffA);
            PG8_WAIT_V(8); PG8_WAIT_L(0); PG8_BAR; PG8_MMA(0, 0, At, B0); PG8_MMA(0, 1, At, B1); PG8_BAR; PG8_SCHED;
            PG8_LDA(At, 1, 1); PG8_STAGE(PG8_SB(1, 0), b3, voffB); PG8_STAGE(PG8_SB(1, 1), b3 + hstep, voffB); PG8_STAGE(PG8_SA(1, 0), a3, voffA);
            PG8_WAIT_V(8); PG8_WAIT_L(0); PG8_BAR; PG8_MMA(1, 0, At, B0); PG8_MMA(1, 1, At, B1); PG8_BAR; PG8_SCHED;
            } else {
            PG8_LDB(B0, 0, 0); PG8_SCHED; PG8_LDA(At, 0, 0); PG8_STAGE(PG8_SA(1, 1), a1 + hstep, voffA);
            PG8_WAIT_L(8); PG8_BAR; PG8_WAIT_L(0); PG8_MMA(0, 0, At, B0); PG8_BAR; PG8_SCHED;
            PG8_LDB(B1, 0, 1); PG8_STAGE(PG8_SB(0, 0), b2, voffB);
            PG8_BAR; PG8_WAIT_L(0); PG8_MMA(0, 1, At, B1); PG8_BAR;
            PG8_LDA(At, 0, 1); PG8_STAGE(PG8_SA(0, 0), a2, voffA);
            PG8_BAR; PG8_WAIT_L(0); PG8_MMA(1, 0, At, B0); PG8_BAR; PG8_SCHED;
            PG8_STAGE(PG8_SB(0, 1), b2 + hstep, voffB);
            PG8_WAIT_V(6); PG8_BAR; PG8_MMA(1, 1, At, B1); PG8_BAR;
            PG8_LDB(B0, 1, 0); PG8_SCHED; PG8_LDA(At, 1, 0); PG8_STAGE(PG8_SA(0, 1), a2 + hstep, voffA);
            PG8_WAIT_L(8); PG8_BAR; PG8_WAIT_L(0); PG8_MMA(0, 0, At, B0); PG8_BAR; PG8_SCHED;
            PG8_LDB(B1, 1, 1); PG8_STAGE(PG8_SB(1, 0), b3, voffB);
            PG8_BAR; PG8_WAIT_L(0); PG8_MMA(0, 1, At, B1); PG8_BAR;
            PG8_LDA(At, 1, 1); PG8_STAGE(PG8_SA(1, 0), a3, voffA);
            PG8_BAR; PG8_WAIT_L(0); PG8_MMA(1, 0, At, B0); PG8_BAR; PG8_SCHED;
            PG8_STAGE(PG8_SB(1, 1), b3 + hstep, voffB);
            PG8_WAIT_V(6); PG8_BAR; PG8_MMA(1, 1, At, B1); PG8_BAR;
            }
        }
        if constexpr (ALIGN_EPI) { if (wr == 0) PG8_BAR; }
        if constexpr (!Epi::AFTER_DRAIN) { E(acc, cur, wr, wc, fr, fq); S.done(cur); }
        if (!has_next) break;
#pragma unroll
        for (int a = 0; a < 2; ++a)
#pragma unroll
            for (int b = 0; b < 2; ++b)
#pragma unroll
                for (int m = 0; m < 4; ++m)
#pragma unroll
                    for (int n = 0; n < 2; ++n) acc[a][b][m][n] = (f32x4){0.f, 0.f, 0.f, 0.f};
        cur = nxt; cA = nA; cB = nB; ++ui;
        if constexpr (ALIGN_EPI) { if (wr == 1) PG8_BAR; }
    }
    PG8_WAIT_V(0);
    if constexpr (!ALIGN_EPI) { if (wr == 0) PG8_BAR; }
    PG8_BAR;
    if constexpr (Epi::AFTER_DRAIN) { E.fused(acc, cur, wr, wc, fr, fq, lds, wid, lane); S.done(cur); }
#undef PG8_SA
#undef PG8_SB
#undef PG8_STAGE
#undef PG8_LDA
#undef PG8_LDB
#undef PG8_MMA
#undef PG8_WAIT_V
#undef PG8_WAIT_L
#undef PG8_BAR
#undef PG8_SCHED
}
}

namespace cg = cooperative_groups;
#define LAS __attribute__((address_space(3)))
typedef unsigned short bf16;
typedef float f32x4 __attribute__((ext_vector_type(4)));
typedef float f32x2 __attribute__((ext_vector_type(2)));
typedef short bf16x8 __attribute__((ext_vector_type(8)));
typedef short s16x4 __attribute__((ext_vector_type(4)));
typedef unsigned u32x4 __attribute__((ext_vector_type(4)));
typedef unsigned u32x2 __attribute__((ext_vector_type(2)));
#define LDS_WAIT() asm volatile("s_waitcnt lgkmcnt(0)" ::: "memory")

constexpr int NT = 98304, NTP = 65536, DM = 1024, ZW = 3200, ZWP = 3328, FFD = 4096, NTH = NT / 2;
constexpr size_t MiB = 1u << 20;
constexpr size_t WS_CTLB = 65536;
constexpr size_t CNT_OFF = 32768;
constexpr size_t WS_WIN = 2 * MiB, WS_WOUT = 15 * MiB, WS_W1 = 19 * MiB, WS_W2 = 35 * MiB, WS_HB = 52 * MiB, WS_ZB = 244 * MiB, WS_HID = 244 * MiB,
                 WS_RAW = 628 * MiB, WS_YB = 844 * MiB, WS_END = 1012 * MiB;
constexpr int LDS_BYTES = 147456;
constexpr int N_SCAN_UNITS = 192, N_ATTN_UNITS = 2304;

struct Args { const float* in[25]; float* out; unsigned char* ws; };
typedef const __attribute__((address_space(4))) Args CArgs;
#define KARGS() ({ CArgs* p_ = (CArgs*)__builtin_amdgcn_kernarg_segment_ptr(); asm volatile("" : "+s"(p_)); p_; })

__device__ __forceinline__ float bf2f(unsigned short u) { return __uint_as_float((unsigned)u << 16); }
__device__ __forceinline__ unsigned f2bf(float f) { unsigned u = __float_as_uint(f); return (u + 0x7fffu + ((u >> 16) & 1u)) >> 16; }
__device__ __forceinline__ unsigned pk2(float lo, float hi) { return f2bf(lo) | (f2bf(hi) << 16); }
__device__ __forceinline__ float wave_sum(float v) {
#pragma unroll
    for (int o = 1; o < 64; o <<= 1) v += __shfl_xor(v, o);
    return v;
}
__device__ __forceinline__ float sigm(float x) { return __builtin_amdgcn_rcpf(1.f + __expf(-x)); }
__device__ __forceinline__ float tanh_(float x) { const float e = __expf(2.f * x); return 1.f - 2.f * __builtin_amdgcn_rcpf(e + 1.f); }
#define DPP_F(v, ctrl) __int_as_float(__builtin_amdgcn_update_dpp(0, __float_as_int(v), (ctrl), 0xF, 0xF, true))
__device__ __forceinline__ float red8(float v) { v += DPP_F(v, 0xB1); v += DPP_F(v, 0x4E); v += DPP_F(v, 0x141); return v; }
__device__ __forceinline__ float wave_sum_fast(float v) {
    v += DPP_F(v, 0xB1); v += DPP_F(v, 0x4E); v += DPP_F(v, 0x141); v += DPP_F(v, 0x140);
    const int vi = __float_as_int(v);
    const float s0 = __int_as_float(__builtin_amdgcn_readlane(vi, 0)), s1 = __int_as_float(__builtin_amdgcn_readlane(vi, 16)), s2 = __int_as_float(__builtin_amdgcn_readlane(vi, 32)), s3 = __int_as_float(__builtin_amdgcn_readlane(vi, 48));
    return (s0 + s1) + (s2 + s3);
}
__device__ __forceinline__ void seq_of(int m, int& T, int& seqbase, int& t) {
    if (m < NTP) { T = 4096; t = m & 4095; } else { T = 2048; t = (m - NTP) & 2047; }
    seqbase = m - t;
}

__device__ __forceinline__ void transpose_item(const float* W, int K, int N, bf16* WT, LAS float* scr, int item, int lane) {
    const int nblk = N / 32, kb = item / nblk, nb = item % nblk, k0 = 64 * kb, n0 = 32 * nb;
    float wv_[32];
#pragma unroll
    for (int i = 0; i < 32; ++i) wv_[i] = W[(size_t)(k0 + 2 * i + (lane >> 5)) * N + n0 + (lane & 31)];
#pragma unroll
    for (int i = 0; i < 32; ++i) scr[(2 * i + (lane >> 5)) * 33 + (lane & 31)] = wv_[i];
    LDS_WAIT();
    const int c = lane & 7;
#pragma unroll
    for (int j = 0; j < 4; ++j) { const int n = (lane >> 3) + 8 * j; const LAS float* s = scr + (8 * c) * 33 + n;
        u32x4 o; o.x = pk2(s[0 * 33], s[1 * 33]); o.y = pk2(s[2 * 33], s[3 * 33]); o.z = pk2(s[4 * 33], s[5 * 33]); o.w = pk2(s[6 * 33], s[7 * 33]);
        *(u32x4*)(WT + (size_t)(n0 + n) * K + k0 + 8 * c) = o; }
    LDS_WAIT();
}
__device__ __forceinline__ void convert_weights(LAS unsigned char* lds, CArgs* ap, int l0, int l1, int wi, int nw, int lane, int wave) {
    LAS float* scr = (LAS float*)(lds + wave * 16384);
    bf16* WIN = (bf16*)(ap->ws + WS_WIN); bf16* WOUT = (bf16*)(ap->ws + WS_WOUT); bf16* W1 = (bf16*)(ap->ws + WS_W1); bf16* W2 = (bf16*)(ap->ws + WS_W2);
    constexpr int I_IN = 16 * 100, I_OUT = 16 * 32, I_1 = 16 * 128, I_2 = 64 * 32, I_L = I_IN + I_OUT + I_1 + I_2;
    for (int it = l0 * I_L + wi; it < l1 * I_L; it += nw) {
        const int l = it / I_L; int r = it % I_L;
        if (r < I_IN) { transpose_item(ap->in[7] + (size_t)l * DM * ZW, DM, ZW, WIN + (size_t)l * ZWP * DM, scr, r, lane); continue; } r -= I_IN;
        if (r < I_OUT) { transpose_item(ap->in[8] + (size_t)l * DM * DM, DM, DM, WOUT + (size_t)l * DM * DM, scr, r, lane); continue; } r -= I_OUT;
        if (r < I_1) { transpose_item(ap->in[23] + (size_t)l * DM * FFD, DM, FFD, W1 + (size_t)l * FFD * DM, scr, r, lane); continue; } r -= I_1;
        transpose_item(ap->in[24] + (size_t)l * FFD * DM, FFD, DM, W2 + (size_t)l * DM * FFD, scr, r, lane);
    }
}
__device__ __forceinline__ void phase_prologue(LAS unsigned char* lds, CArgs* ap, int gw, int NGW, int lane, int wave) {
    bf16* WIN = (bf16*)(ap->ws + WS_WIN);
    convert_weights(lds, ap, 0, ((int)gridDim.x > N_SCAN_UNITS) ? 1 : 2, gw, NGW, lane, wave);
    for (int i = gw * 64 + lane; i < 2 * 16384; i += NGW * 64) { const int l = i >> 14, o = i & 16383;
        *(u32x4*)(WIN + (size_t)l * ZWP * DM + (size_t)ZW * DM + (size_t)o * 8) = (u32x4){0u, 0u, 0u, 0u}; }
}

__device__ __forceinline__ void phase_norm0(const float* xp, const float* xs, const float* g, bf16* HB, int gw, int NGW, int lane) {
    f32x4 vn[4];
#define N0_LOAD(m_) do { const int mm_ = (m_); const float* xr_ = (mm_ < NTP) ? xp + (size_t)mm_ * DM : xs + (size_t)(mm_ - NTP) * DM; \
        _Pragma("unroll") for (int j = 0; j < 4; ++j) vn[j] = *(const f32x4*)(xr_ + 4 * lane + 256 * j); } while (0)
    if (gw < NT) N0_LOAD(gw);
#pragma unroll 1
    for (int m = gw; m < NT; m += NGW) {
        f32x4 v[4]; float ss = 0.f;
#pragma unroll
        for (int j = 0; j < 4; ++j) { v[j] = vn[j]; ss += (v[j].x * v[j].x + v[j].y * v[j].y) + (v[j].z * v[j].z + v[j].w * v[j].w); }
        if (m + NGW < NT) N0_LOAD(m + NGW);
        ss = wave_sum_fast(ss); const float rs = rsqrtf(ss * (1.f / DM) + 1e-6f);
#pragma unroll
        for (int j = 0; j < 4; ++j) { const f32x4 gg = *(const f32x4*)(g + 4 * lane + 256 * j);
            u32x2 o; o.x = pk2(v[j].x * rs * gg.x, v[j].y * rs * gg.y); o.y = pk2(v[j].z * rs * gg.z, v[j].w * rs * gg.w);
            *(u32x2*)(HB + (size_t)m * DM + 4 * lane + 256 * j) = o; }
    }
#undef N0_LOAD
}
__device__ __forceinline__ void phase_resid(const float* xp, const float* xs, bool from_in, float* out, const bf16* RAW, const float* gpost, const float* gnext, bf16* HB,
                                            int gw, int NGW, int lane) {
    u32x2 rwn[4]; f32x4 xn[4];
#define RS_LOAD(m_) do { const int mm_ = (m_); const float* xr_ = from_in ? ((mm_ < NTP) ? xp + (size_t)mm_ * DM : xs + (size_t)(mm_ - NTP) * DM) : out + (size_t)mm_ * DM; \
        _Pragma("unroll") for (int j = 0; j < 4; ++j) { rwn[j] = *(const u32x2*)(RAW + (size_t)mm_ * DM + 4 * lane + 256 * j); xn[j] = *(const f32x4*)(xr_ + 4 * lane + 256 * j); } } while (0)
    if (gw < NT) RS_LOAD(gw);
#pragma unroll 1
    for (int m = gw; m < NT; m += NGW) {
        u32x2 rw[4]; f32x4 x[4];
#pragma unroll
        for (int j = 0; j < 4; ++j) { rw[j] = rwn[j]; x[j] = xn[j]; }
        if (m + NGW < NT) RS_LOAD(m + NGW);
        f32x4 r[4]; float sr = 0.f;
#pragma unroll
        for (int j = 0; j < 4; ++j) {
            r[j].x = __uint_as_float(rw[j].x << 16); r[j].y = __uint_as_float(rw[j].x & 0xffff0000u); r[j].z = __uint_as_float(rw[j].y << 16); r[j].w = __uint_as_float(rw[j].y & 0xffff0000u);
            sr += (r[j].x * r[j].x + r[j].y * r[j].y) + (r[j].z * r[j].z + r[j].w * r[j].w); }
        sr = wave_sum_fast(sr); const float rs = rsqrtf(sr * (1.f / DM) + 1e-6f);
        f32x4 v[4]; float ss = 0.f;
#pragma unroll
        for (int j = 0; j < 4; ++j) {
            const f32x4 gp = *(const f32x4*)(gpost + 4 * lane + 256 * j);
            v[j] = x[j] + r[j] * rs * gp;
            ss += (v[j].x * v[j].x + v[j].y * v[j].y) + (v[j].z * v[j].z + v[j].w * v[j].w);
            *(f32x4*)(out + (size_t)m * DM + 4 * lane + 256 * j) = v[j];
        }
        if (gnext) {
            ss = wave_sum_fast(ss); const float rs2 = rsqrtf(ss * (1.f / DM) + 1e-6f);
#pragma unroll
            for (int j = 0; j < 4; ++j) { const f32x4 gg = *(const f32x4*)(gnext + 4 * lane + 256 * j);
                u32x2 o; o.x = pk2(v[j].x * rs2 * gg.x, v[j].y * rs2 * gg.y); o.y = pk2(v[j].z * rs2 * gg.z, v[j].w * rs2 * gg.w);
                *(u32x2*)(HB + (size_t)m * DM + 4 * lane + 256 * j) = o; }
        }
    }
#undef RS_LOAD
}

__device__ __forceinline__ float bflo(unsigned u) { return __uint_as_float(u << 16); }
__device__ __forceinline__ float bfhi(unsigned u) { return __uint_as_float(u & 0xffff0000u); }
__device__ __forceinline__ void unpack8(const u32x4 w, float (&f)[8]) { f[0] = bflo(w.x); f[1] = bfhi(w.x); f[2] = bflo(w.y); f[3] = bfhi(w.y); f[4] = bflo(w.z); f[5] = bfhi(w.z); f[6] = bflo(w.w); f[7] = bfhi(w.w); }
__device__ __forceinline__ u32x4 pack8(const float (&f)[8]) { u32x4 w; w.x = pk2(f[0], f[1]); w.y = pk2(f[2], f[3]); w.z = pk2(f[4], f[5]); w.w = pk2(f[6], f[7]); return w; }
__device__ __forceinline__ void unpack4(const u32x2 w, float (&f)[4]) { f[0] = bflo(w.x); f[1] = bfhi(w.x); f[2] = bflo(w.y); f[3] = bfhi(w.y); }
#define SC_TOK(p, c) (((p) >> 4) ? (T - 1 - (16 * (c) + ((p) & 15))) : (16 * (c) + ((p) & 15)))
#define DPP_SHR(v, n) __int_as_float(__builtin_amdgcn_update_dpp(0, __float_as_int(v), 0x110 + (n), 0xF, 0xF, true))
constexpr int SCB = 21504;
__device__ __forceinline__ void scan_unit(LAS unsigned char* lds, const bf16* ZB, float* YB, CArgs* ap, int l, int su, int tid, int lane, int wave) {
    const int seq = su / 6, h = su % 6;
    int T, seqbase; if (seq < 16) { T = 4096; seqbase = seq * 4096; } else { T = 2048; seqbase = NTP + (seq - 16) * 2048; }
    const int dir = wave >> 2, q = wave & 3, x = lane & 15, kg = lane >> 4;
    LAS unsigned short* YLh = (LAS unsigned short*)lds;
#define TWLB(p) ((LAS unsigned short*)(lds + 8192 + (dir * 2 + (p)) * 2304))
    const int hcq = h * 64 + 16 * q, c0 = hcq + 4 * kg;
    const f32x4 zf = (f32x4){0.f, 0.f, 0.f, 0.f};
    bf16x8 Ww, Wa;
    {   const float* dup = ap->in[14] + (size_t)(l * 2 + dir) * 32 * 384; const float* iup = ap->in[16] + (size_t)(l * 2 + dir) * 32 * 384; float t8[8];
#pragma unroll
        for (int e = 0; e < 8; ++e) t8[e] = dup[(8 * kg + e) * 384 + hcq + x];
        Ww = __builtin_bit_cast(bf16x8, pack8(t8));
#pragma unroll
        for (int e = 0; e < 8; ++e) t8[e] = iup[(8 * kg + e) * 384 + hcq + x];
        Wa = __builtin_bit_cast(bf16x8, pack8(t8)); }
    const float* mu = ap->in[12] + l * 1280;
    const f32x4 w0v = *(const f32x4*)(ap->in[13] + (l * 2 + dir) * 384 + c0), a0v = *(const f32x4*)(ap->in[15] + (l * 2 + dir) * 384 + c0);
    const f32x4 kkv = *(const f32x4*)(ap->in[18] + l * 384 + c0), kav = *(const f32x4*)(ap->in[19] + l * 384 + c0);
    const f32x4 murv = *(const f32x4*)(mu + c0), mukv = *(const f32x4*)(mu + 384 + c0), muvv = *(const f32x4*)(mu + 768 + c0);
    const float muwq0 = mu[1152 + 8 * kg + 2 * q], muwq1 = mu[1153 + 8 * kg + 2 * q], muaq0 = mu[1184 + 8 * kg + 2 * q], muaq1 = mu[1185 + 8 * kg + 2 * q];
    const bf16* zrow0 = ZB + (size_t)seqbase * ZW;
    const bf16* zero_row = (const bf16*)ap->ws;
    const int p1 = tid >> 4, q1 = tid & 15, nch = T / 16;
    f32x4 ST[4];
#pragma unroll
    for (int jt = 0; jt < 4; ++jt) ST[jt] = zf;
    u32x2 zrA_[3][3], zrB_[3][3]; unsigned bwA_[3], baA_[3], bwB_[3], baB_[3];
    const u32x4 z4 = (u32x4){0u, 0u, 0u, 0u}; const u32x2 z2 = (u32x2){0u, 0u}; (void)z4; (void)z2;
#define SC_ROWS(c) const int t_ = SC_TOK(dir * 16 + x, (c)); const bf16* zc_ = zrow0 + (size_t)t_ * ZW; \
        const bf16* zp_ = (t_ > 0) ? zc_ - ZW : zero_row; const bf16* zn_ = (t_ < T - 1) ? zc_ + ZW : zero_row
#define SC_LOAD(ZR, c) do { SC_ROWS(c); \
        _Pragma("unroll") for (int qq = 0; qq < 3; ++qq) { ZR[1][qq] = *(const u32x2*)(zc_ + 1920 + 384 * qq + c0); ZR[0][qq] = *(const u32x2*)(zp_ + 1920 + 384 * qq + c0); ZR[2][qq] = *(const u32x2*)(zn_ + 1920 + 384 * qq + c0); } } while (0)
#define SC_LOAD0(BW, BA, c) do { SC_ROWS(c); BW[1] = *(const unsigned*)(zc_ + 3072 + 8 * kg + 2 * q); BW[0] = *(const unsigned*)(zp_ + 3072 + 8 * kg + 2 * q); BW[2] = *(const unsigned*)(zn_ + 3072 + 8 * kg + 2 * q); \
        BA[1] = *(const unsigned*)(zc_ + 3104 + 8 * kg + 2 * q); BA[0] = *(const unsigned*)(zp_ + 3104 + 8 * kg + 2 * q); BA[2] = *(const unsigned*)(zn_ + 3104 + 8 * kg + 2 * q); } while (0)
#define SC_B0(BW, BA, par) do { LAS unsigned short* tw_ = TWLB(par); \
        const float w0_ = tanh_(bflo(BW[1]) + (0.5f * (bflo(BW[0]) + bflo(BW[2])) - bflo(BW[1])) * muwq0), w1_ = tanh_(bfhi(BW[1]) + (0.5f * (bfhi(BW[0]) + bfhi(BW[2])) - bfhi(BW[1])) * muwq1); \
        const float a0_ = bflo(BA[1]) + (0.5f * (bflo(BA[0]) + bflo(BA[2])) - bflo(BA[1])) * muaq0, a1_ = bfhi(BA[1]) + (0.5f * (bfhi(BA[0]) + bfhi(BA[2])) - bfhi(BA[1])) * muaq1; \
        *(LAS unsigned*)(tw_ + x * 72 + 8 * kg + 2 * q) = HWPK(w0_, w1_); *(LAS unsigned*)(tw_ + x * 72 + 32 + 8 * kg + 2 * q) = HWPK(a0_, a1_); } while (0)
#define CBUF3(i) (lds + 17408 + (dir * 3 + (i)) * SCB)
#define P_CAT(cb) ((LAS unsigned short*)(cb))
#define P_CRT(cb) ((LAS unsigned short*)((cb) + 2304))
#define P_CBT(cb) ((LAS unsigned short*)((cb) + 4608))
#define P_CKT(cb) ((LAS unsigned short*)((cb) + 6912))
#define P_CBJ(cb) ((LAS unsigned short*)((cb) + 9216))
#define P_CKJ(cb) ((LAS unsigned short*)((cb) + 11776))
#define P_CBM(cb) ((LAS unsigned short*)((cb) + 14336))
#define P_CTT(cb) ((LAS unsigned short*)((cb) + 14976))
#define P_CAY(cb) ((LAS unsigned short*)((cb) + 15616))
#define P_CBY(cb) ((LAS unsigned short*)((cb) + 16256))
#define P_AFT(cb) ((LAS float*)((cb) + 16896))
#define P_CGC(cb) ((LAS float*)((cb) + 17984))
#define P_CVI(cb) ((LAS unsigned short*)((cb) + 18240))
#define P_NP(cb) ((LAS float*)((cb) + 20800))
#define SC_BAR() do { asm volatile("s_waitcnt lgkmcnt(0)" ::: "memory"); __builtin_amdgcn_s_barrier(); asm volatile("" ::: "memory"); } while (0)
#define HWPK(lo, hi) pg8::cvt_pk_bf16((lo), (hi))
    SC_LOAD(zrA_, 0); SC_LOAD(zrB_, min(1, nch - 1));
    SC_LOAD0(bwA_, baA_, 0); SC_B0(bwA_, baA_, 0); SC_LOAD0(bwA_, baA_, min(1, nch - 1)); SC_LOAD0(bwB_, baB_, min(2, nch - 1));
    SC_BAR();
    float rr[4], vv[4], lw[4], av[4], kq[4], kd[4];
    int r0 = 0;
#pragma unroll 1
    for (int k0 = -3; k0 < nch; k0 += 2) {
      { const int k = k0;
        const int r1 = (r0 == 2) ? 0 : r0 + 1, r2 = (r1 == 2) ? 0 : r1 + 1;
        {
            LAS unsigned char* cb = CBUF3(r2);
            const LAS float* NP = P_NP(cb);
            const float n2t = (NP[x] + NP[16 + x]) + (NP[32 + x] + NP[48 + x]); const float rnm = __builtin_amdgcn_rcpf(fmaxf(sqrtf(n2t), 1e-12f));
            float at[4], rt[4], bt[4], kt[4], gg[4];
#pragma unroll
            for (int e = 0; e < 4; ++e) { const float kk = kq[e] * rnm, bb = kk * av[e];
                float L = lw[e]; L += DPP_SHR(L, 1); L += DPP_SHR(L, 2); L += DPP_SHR(L, 4); L += DPP_SHR(L, 8);
                const float g = __expf(L), gm = __expf(L - lw[e]), gi = __expf(-L);
                at[e] = -kk * gm; rt[e] = rr[e] * g; bt[e] = bb * gi; kt[e] = kd[e] * gi; gg[e] = g; }
            u32x2 w2;
            w2.x = HWPK(at[0], at[1]); w2.y = HWPK(at[2], at[3]); *(LAS u32x2*)(P_CAT(cb) + x * 72 + 16 * q + 4 * kg) = w2;
            w2.x = HWPK(rt[0], rt[1]); w2.y = HWPK(rt[2], rt[3]); *(LAS u32x2*)(P_CRT(cb) + x * 72 + 16 * q + 4 * kg) = w2;
            const unsigned b01 = HWPK(bt[0], bt[1]), b23 = HWPK(bt[2], bt[3]), k01 = HWPK(kt[0], kt[1]), k23 = HWPK(kt[2], kt[3]), v01 = HWPK(vv[0], vv[1]), v23 = HWPK(vv[2], vv[3]);
            w2.x = b01; w2.y = b23; *(LAS u32x2*)(P_CBT(cb) + x * 72 + 16 * q + 4 * kg) = w2;
            w2.x = k01; w2.y = k23; *(LAS u32x2*)(P_CKT(cb) + x * 72 + 16 * q + 4 * kg) = w2;
            {   const int jr = 16 * q + 4 * kg; LAS unsigned short* bj = P_CBJ(cb) + jr * 20 + x; LAS unsigned short* kj = P_CKJ(cb) + jr * 20 + x; LAS unsigned short* vi = P_CVI(cb) + jr * 20 + x;
                bj[0] = (unsigned short)(b01 & 0xffffu); bj[20] = (unsigned short)(b01 >> 16); bj[40] = (unsigned short)(b23 & 0xffffu); bj[60] = (unsigned short)(b23 >> 16);
                kj[0] = (unsigned short)(k01 & 0xffffu); kj[20] = (unsigned short)(k01 >> 16); kj[40] = (unsigned short)(k23 & 0xffffu); kj[60] = (unsigned short)(k23 >> 16);
                vi[0] = (unsigned short)(v01 & 0xffffu); vi[20] = (unsigned short)(v01 >> 16); vi[40] = (unsigned short)(v23 & 0xffffu); vi[60] = (unsigned short)(v23 >> 16); }
            if (x == 15) *(LAS f32x4*)(P_CGC(cb) + 16 * q + 4 * kg) = (f32x4){gg[0], gg[1], gg[2], gg[3]};
        }
        {
            LAS unsigned char* cb = CBUF3(r0);
            const LAS unsigned short* tw = TWLB((k + 3) & 1);
            const bf16x8 TWb = *(const LAS bf16x8*)(tw + x * 72 + 8 * kg), TAb = *(const LAS bf16x8*)(tw + x * 72 + 32 + 8 * kg);
            const f32x4 Cw = __builtin_amdgcn_mfma_f32_16x16x32_bf16(Ww, TWb, zf, 0, 0, 0), Ca = __builtin_amdgcn_mfma_f32_16x16x32_bf16(Wa, TAb, zf, 0, 0, 0);
            float rc[4], rp[4], rn[4], kc[4], kp[4], kn[4], vc[4], vp[4], vn[4];
            unpack4(zrA_[1][0], rc); unpack4(zrA_[0][0], rp); unpack4(zrA_[2][0], rn); unpack4(zrA_[1][1], kc); unpack4(zrA_[0][1], kp); unpack4(zrA_[2][1], kn);
            unpack4(zrA_[1][2], vc); unpack4(zrA_[0][2], vp); unpack4(zrA_[2][2], vn);
            float n2 = 0.f;
#pragma unroll
            for (int e = 0; e < 4; ++e) {
                rr[e] = rc[e] + (0.5f * (rp[e] + rn[e]) - rc[e]) * murv[e]; const float kk0 = kc[e] + (0.5f * (kp[e] + kn[e]) - kc[e]) * mukv[e]; vv[e] = vc[e] + (0.5f * (vp[e] + vn[e]) - vc[e]) * muvv[e];
                lw[e] = -0.6065306597f * sigm(w0v[e] + Cw[e]); av[e] = sigm(a0v[e] + Ca[e]);
                kq[e] = kk0 * kkv[e]; n2 += kq[e] * kq[e]; kd[e] = kk0 * (1.f + (av[e] - 1.f) * kav[e]);
            }
            n2 += __shfl_xor(n2, 16); n2 += __shfl_xor(n2, 32);
            if (kg == 0) P_NP(cb)[q * 16 + x] = n2;
        }
        SC_LOAD(zrA_, min(k + 5, nch - 1));
        SC_B0(bwA_, baA_, (k + 4) & 1); SC_LOAD0(bwA_, baA_, min(k + 6, nch - 1));
        {
            LAS unsigned char* cb = CBUF3(r1);
            const int rq = (q - dir) & 3;
            const LAS unsigned short* F = (rq < 2) ? P_CAT(cb) : P_CRT(cb); const LAS unsigned short* S2 = (rq & 1) ? P_CKT(cb) : P_CBT(cb);
            const bf16x8 F0 = *(const LAS bf16x8*)(F + x * 72 + 8 * kg), F1 = *(const LAS bf16x8*)(F + x * 72 + 32 + 8 * kg);
            const bf16x8 S0 = *(const LAS bf16x8*)(S2 + x * 72 + 8 * kg), S1 = *(const LAS bf16x8*)(S2 + x * 72 + 32 + 8 * kg);
            f32x4 G = __builtin_amdgcn_mfma_f32_16x16x32_bf16(F0, S0, zf, 0, 0, 0); G = __builtin_amdgcn_mfma_f32_16x16x32_bf16(F1, S1, G, 0, 0, 0);
            if (rq == 0) {
#define SC_PROD(FI, SE) ({ f32x4 a_ = zf; a_ = __builtin_amdgcn_mfma_f32_16x16x4f32((FI)[0], (SE)[0], a_, 0, 0, 0); a_ = __builtin_amdgcn_mfma_f32_16x16x4f32((FI)[1], (SE)[1], a_, 0, 0, 0); \
                    a_ = __builtin_amdgcn_mfma_f32_16x16x4f32((FI)[2], (SE)[2], a_, 0, 0, 0); a_ = __builtin_amdgcn_mfma_f32_16x16x4f32((FI)[3], (SE)[3], a_, 0, 0, 0); a_; })
                f32x4 Gc = __builtin_amdgcn_mfma_f32_16x16x32_bf16(S0, F0, zf, 0, 0, 0); Gc = __builtin_amdgcn_mfma_f32_16x16x32_bf16(S1, F1, Gc, 0, 0, 0);
                f32x4 R1, C1, CT;
#pragma unroll
                for (int e = 0; e < 4; ++e) { const int y_ = 4 * kg + e; R1[e] = (x < y_) ? G[e] : 0.f; C1[e] = (y_ < x) ? Gc[e] : 0.f; CT[e] = C1[e] + ((y_ == x) ? 1.f : 0.f); }
                const f32x4 R2 = SC_PROD(C1, R1), C2 = SC_PROD(R1, C1);
                CT = CT + SC_PROD(R2, CT);
                const f32x4 R4 = SC_PROD(C2, R2), C4 = SC_PROD(R2, C2);
                CT = CT + SC_PROD(R4, CT);
                const f32x4 R8 = SC_PROD(C4, R4);
                CT = CT + SC_PROD(R8, CT);
#undef SC_PROD
                u32x2 wt; wt.x = pk2(CT[0], CT[1]); wt.y = pk2(CT[2], CT[3]);
                *(LAS u32x2*)(P_CTT(cb) + x * 20 + 4 * kg) = wt;
            } else {
                LAS unsigned short* D = (rq == 1) ? P_CBM(cb) : ((rq == 2) ? P_CAY(cb) : P_CBY(cb));
#pragma unroll
                for (int e = 0; e < 4; ++e) { const int sx = 4 * kg + e; const bool keep = (rq == 1) ? (x < sx) : (x <= sx); D[sx * 20 + x] = (unsigned short)f2bf(keep ? G[e] : 0.f); }
            }
        }
        {
            LAS unsigned char* cb = CBUF3(r0);
            u32x4 t4;
            t4.x = HWPK(ST[0][0], ST[0][1]); t4.y = HWPK(ST[0][2], ST[0][3]); t4.z = HWPK(ST[1][0], ST[1][1]); t4.w = HWPK(ST[1][2], ST[1][3]);
            const bf16x8 SO0 = __builtin_bit_cast(bf16x8, t4);
            t4.x = HWPK(ST[2][0], ST[2][1]); t4.y = HWPK(ST[2][2], ST[2][3]); t4.z = HWPK(ST[3][0], ST[3][1]); t4.w = HWPK(ST[3][2], ST[3][3]);
            const bf16x8 SO1 = __builtin_bit_cast(bf16x8, t4);
#define SC_JOP(base, ks) ({ const u32x2 lo_ = *(const LAS u32x2*)((base) + x * 72 + 32 * (ks) + 4 * kg), hi_ = *(const LAS u32x2*)((base) + x * 72 + 32 * (ks) + 16 + 4 * kg); u32x4 w_; w_.x = lo_.x; w_.y = lo_.y; w_.z = hi_.x; w_.w = hi_.y; __builtin_bit_cast(bf16x8, w_); })
#define SC_UOP(base, row) ({ const u32x2 lo_ = *(const LAS u32x2*)((base) + (row) * 20 + 4 * kg); u32x4 w_; w_.x = lo_.x; w_.y = lo_.y; w_.z = 0u; w_.w = 0u; __builtin_bit_cast(bf16x8, w_); })
#define SC_COP(v) ({ u32x4 w_; w_.x = pk2((v)[0], (v)[1]); w_.y = pk2((v)[2], (v)[3]); w_.z = 0u; w_.w = 0u; __builtin_bit_cast(bf16x8, w_); })
            f32x4 RH = __builtin_amdgcn_mfma_f32_16x16x32_bf16(SC_JOP(P_CAT(cb), 0), SO0, zf, 0, 0, 0); RH = __builtin_amdgcn_mfma_f32_16x16x32_bf16(SC_JOP(P_CAT(cb), 1), SO1, RH, 0, 0, 0);
            const bf16x8 VO = SC_UOP(P_CVI(cb), 16 * q + x);
            RH = __builtin_amdgcn_mfma_f32_16x16x32_bf16(SC_UOP(P_CBM(cb), x), VO, RH, 0, 0, 0);
            const bf16x8 RO = SC_COP(RH);
            const f32x4 SA = __builtin_amdgcn_mfma_f32_16x16x32_bf16(SC_UOP(P_CTT(cb), x), RO, zf, 0, 0, 0);
            const bf16x8 SAO = SC_COP(SA);
            f32x4 Y = __builtin_amdgcn_mfma_f32_16x16x32_bf16(SC_JOP(P_CRT(cb), 0), SO0, zf, 0, 0, 0); Y = __builtin_amdgcn_mfma_f32_16x16x32_bf16(SC_JOP(P_CRT(cb), 1), SO1, Y, 0, 0, 0);
            Y = __builtin_amdgcn_mfma_f32_16x16x32_bf16(SC_UOP(P_CAY(cb), x), SAO, Y, 0, 0, 0); Y = __builtin_amdgcn_mfma_f32_16x16x32_bf16(SC_UOP(P_CBY(cb), x), VO, Y, 0, 0, 0);
#pragma unroll
            for (int e = 0; e < 4; ++e) (YLh + ((k & 1) ? 2048 : 0))[(dir * 16 + 4 * kg + e) * 64 + 16 * q + x] = (unsigned short)f2bf(Y[e]);
#pragma unroll
            for (int jt = 0; jt < 4; ++jt) {
                ST[jt] = __builtin_amdgcn_mfma_f32_16x16x32_bf16(SC_UOP(P_CBJ(cb), 16 * jt + x), SAO, ST[jt], 0, 0, 0);
                ST[jt] = __builtin_amdgcn_mfma_f32_16x16x32_bf16(SC_UOP(P_CKJ(cb), 16 * jt + x), VO, ST[jt], 0, 0, 0);
                ST[jt] = ST[jt] * *(const LAS f32x4*)(P_CGC(cb) + 16 * jt + 4 * kg);
            }
#undef SC_JOP
#undef SC_UOP
#undef SC_COP
        }
        if (k < 0) {
#pragma unroll
            for (int jt = 0; jt < 4; ++jt) ST[jt] = zf; }
        if (k >= 1) {
            const int cc = k - 1;
            const int t = SC_TOK(p1, cc); bf16* dst = (bf16*)YB + (size_t)(p1 >> 4) * NT * 384 + (size_t)(seqbase + t) * 384 + h * 64 + 4 * q1; const u32x2 w = *(const LAS u32x2*)(YLh + ((cc & 1) ? 2048 : 0) + p1 * 64 + 4 * q1);
            *(u32x2*)dst = w;
        }
        SC_BAR();
        r0 = r1;
      }
      { const int k = k0 + 1;
        const int r1 = (r0 == 2) ? 0 : r0 + 1, r2 = (r1 == 2) ? 0 : r1 + 1;
        {
            LAS unsigned char* cb = CBUF3(r2);
            const LAS float* NP = P_NP(cb);
            const float n2t = (NP[x] + NP[16 + x]) + (NP[32 + x] + NP[48 + x]); const float rnm = __builtin_amdgcn_rcpf(fmaxf(sqrtf(n2t), 1e-12f));
            float at[4], rt[4], bt[4], kt[4], gg[4];
#pragma unroll
            for (int e = 0; e < 4; ++e) { const float kk = kq[e] * rnm, bb = kk * av[e];
                float L = lw[e]; L += DPP_SHR(L, 1); L += DPP_SHR(L, 2); L += DPP_SHR(L, 4); L += DPP_SHR(L, 8);
                const float g = __expf(L), gm = __expf(L - lw[e]), gi = __expf(-L);
                at[e] = -kk * gm; rt[e] = rr[e] * g; bt[e] = bb * gi; kt[e] = kd[e] * gi; gg[e] = g; }
            u32x2 w2;
            w2.x = HWPK(at[0], at[1]); w2.y = HWPK(at[2], at[3]); *(LAS u32x2*)(P_CAT(cb) + x * 72 + 16 * q + 4 * kg) = w2;
            w2.x = HWPK(rt[0], rt[1]); w2.y = HWPK(rt[2], rt[3]); *(LAS u32x2*)(P_CRT(cb) + x * 72 + 16 * q + 4 * kg) = w2;
            const unsigned b01 = HWPK(bt[0], bt[1]), b23 = HWPK(bt[2], bt[3]), k01 = HWPK(kt[0], kt[1]), k23 = HWPK(kt[2], kt[3]), v01 = HWPK(vv[0], vv[1]), v23 = HWPK(vv[2], vv[3]);
            w2.x = b01; w2.y = b23; *(LAS u32x2*)(P_CBT(cb) + x * 72 + 16 * q + 4 * kg) = w2;
            w2.x = k01; w2.y = k23; *(LAS u32x2*)(P_CKT(cb) + x * 72 + 16 * q + 4 * kg) = w2;
            {   const int jr = 16 * q + 4 * kg; LAS unsigned short* bj = P_CBJ(cb) + jr * 20 + x; LAS unsigned short* kj = P_CKJ(cb) + jr * 20 + x; LAS unsigned short* vi = P_CVI(cb) + jr * 20 + x;
                bj[0] = (unsigned short)(b01 & 0xffffu); bj[20] = (unsigned short)(b01 >> 16); bj[40] = (unsigned short)(b23 & 0xffffu); bj[60] = (unsigned short)(b23 >> 16);
                kj[0] = (unsigned short)(k01 & 0xffffu); kj[20] = (unsigned short)(k01 >> 16); kj[40] = (unsigned short)(k23 & 0xffffu); kj[60] = (unsigned short)(k23 >> 16);
                vi[0] = (unsigned short)(v01 & 0xffffu); vi[20] = (unsigned short)(v01 >> 16); vi[40] = (unsigned short)(v23 & 0xffffu); vi[60] = (unsigned short)(v23 >> 16); }
            if (x == 15) *(LAS f32x4*)(P_CGC(cb) + 16 * q + 4 * kg) = (f32x4){gg[0], gg[1], gg[2], gg[3]};
        }
        {
            LAS unsigned char* cb = CBUF3(r0);
            const LAS unsigned short* tw = TWLB((k + 3) & 1);
            const bf16x8 TWb = *(const LAS bf16x8*)(tw + x * 72 + 8 * kg), TAb = *(const LAS bf16x8*)(tw + x * 72 + 32 + 8 * kg);
            const f32x4 Cw = __builtin_amdgcn_mfma_f32_16x16x32_bf16(Ww, TWb, zf, 0, 0, 0), Ca = __builtin_amdgcn_mfma_f32_16x16x32_bf16(Wa, TAb, zf, 0, 0, 0);
            float rc[4], rp[4], rn[4], kc[4], kp[4], kn[4], vc[4], vp[4], vn[4];
            unpack4(zrB_[1][0], rc); unpack4(zrB_[0][0], rp); unpack4(zrB_[2][0], rn); unpack4(zrB_[1][1], kc); unpack4(zrB_[0][1], kp); unpack4(zrB_[2][1], kn);
            unpack4(zrB_[1][2], vc); unpack4(zrB_[0][2], vp); unpack4(zrB_[2][2], vn);
            float n2 = 0.f;
#pragma unroll
            for (int e = 0; e < 4; ++e) {
                rr[e] = rc[e] + (0.5f * (rp[e] + rn[e]) - rc[e]) * murv[e]; const float kk0 = kc[e] + (0.5f * (kp[e] + kn[e]) - kc[e]) * mukv[e]; vv[e] = vc[e] + (0.5f * (vp[e] + vn[e]) - vc[e]) * muvv[e];
                lw[e] = -0.6065306597f * sigm(w0v[e] + Cw[e]); av[e] = sigm(a0v[e] + Ca[e]);
                kq[e] = kk0 * kkv[e]; n2 += kq[e] * kq[e]; kd[e] = kk0 * (1.f + (av[e] - 1.f) * kav[e]);
            }
            n2 += __shfl_xor(n2, 16); n2 += __shfl_xor(n2, 32);
            if (kg == 0) P_NP(cb)[q * 16 + x] = n2;
        }
        SC_LOAD(zrB_, min(k + 5, nch - 1));
        SC_B0(bwB_, baB_, (k + 4) & 1); SC_LOAD0(bwB_, baB_, min(k + 6, nch - 1));
        {
            LAS unsigned char* cb = CBUF3(r1);
            const int rq = (q - dir) & 3;
            const LAS unsigned short* F = (rq < 2) ? P_CAT(cb) : P_CRT(cb); const LAS unsigned short* S2 = (rq & 1) ? P_CKT(cb) : P_CBT(cb);
            const bf16x8 F0 = *(const LAS bf16x8*)(F + x * 72 + 8 * kg), F1 = *(const LAS bf16x8*)(F + x * 72 + 32 + 8 * kg);
            const bf16x8 S0 = *(const LAS bf16x8*)(S2 + x * 72 + 8 * kg), S1 = *(const LAS bf16x8*)(S2 + x * 72 + 32 + 8 * kg);
            f32x4 G = __builtin_amdgcn_mfma_f32_16x16x32_bf16(F0, S0, zf, 0, 0, 0); G = __builtin_amdgcn_mfma_f32_16x16x32_bf16(F1, S1, G, 0, 0, 0);
            if (rq == 0) {
#define SC_PROD(FI, SE) ({ f32x4 a_ = zf; a_ = __builtin_amdgcn_mfma_f32_16x16x4f32((FI)[0], (SE)[0], a_, 0, 0, 0); a_ = __builtin_amdgcn_mfma_f32_16x16x4f32((FI)[1], (SE)[1], a_, 0, 0, 0); \
                    a_ = __builtin_amdgcn_mfma_f32_16x16x4f32((FI)[2], (SE)[2], a_, 0, 0, 0); a_ = __builtin_amdgcn_mfma_f32_16x16x4f32((FI)[3], (SE)[3], a_, 0, 0, 0); a_; })
                f32x4 Gc = __builtin_amdgcn_mfma_f32_16x16x32_bf16(S0, F0, zf, 0, 0, 0); Gc = __builtin_amdgcn_mfma_f32_16x16x32_bf16(S1, F1, Gc, 0, 0, 0);
                f32x4 R1, C1, CT;
#pragma unroll
                for (int e = 0; e < 4; ++e) { const int y_ = 4 * kg + e; R1[e] = (x < y_) ? G[e] : 0.f; C1[e] = (y_ < x) ? Gc[e] : 0.f; CT[e] = C1[e] + ((y_ == x) ? 1.f : 0.f); }
                const f32x4 R2 = SC_PROD(C1, R1), C2 = SC_PROD(R1, C1);
                CT = CT + SC_PROD(R2, CT);
                const f32x4 R4 = SC_PROD(C2, R2), C4 = SC_PROD(R2, C2);
                CT = CT + SC_PROD(R4, CT);
                const f32x4 R8 = SC_PROD(C4, R4);
                CT = CT + SC_PROD(R8, CT);
#undef SC_PROD
                u32x2 wt; wt.x = pk2(CT[0], CT[1]); wt.y = pk2(CT[2], CT[3]);
                *(LAS u32x2*)(P_CTT(cb) + x * 20 + 4 * kg) = wt;
            } else {
                LAS unsigned short* D = (rq == 1) ? P_CBM(cb) : ((rq == 2) ? P_CAY(cb) : P_CBY(cb));
#pragma unroll
                for (int e = 0; e < 4; ++e) { const int sx = 4 * kg + e; const bool keep = (rq == 1) ? (x < sx) : (x <= sx); D[sx * 20 + x] = (unsigned short)f2bf(keep ? G[e] : 0.f); }
            }
        }
        {
            LAS unsigned char* cb = CBUF3(r0);
            u32x4 t4;
            t4.x = HWPK(ST[0][0], ST[0][1]); t4.y = HWPK(ST[0][2], ST[0][3]); t4.z = HWPK(ST[1][0], ST[1][1]); t4.w = HWPK(ST[1][2], ST[1][3]);
            const bf16x8 SO0 = __builtin_bit_cast(bf16x8, t4);
            t4.x = HWPK(ST[2][0], ST[2][1]); t4.y = HWPK(ST[2][2], ST[2][3]); t4.z = HWPK(ST[3][0], ST[3][1]); t4.w = HWPK(ST[3][2], ST[3][3]);
            const bf16x8 SO1 = __builtin_bit_cast(bf16x8, t4);
#define SC_JOP(base, ks) ({ const u32x2 lo_ = *(const LAS u32x2*)((base) + x * 72 + 32 * (ks) + 4 * kg), hi_ = *(const LAS u32x2*)((base) + x * 72 + 32 * (ks) + 16 + 4 * kg); u32x4 w_; w_.x = lo_.x; w_.y = lo_.y; w_.z = hi_.x; w_.w = hi_.y; __builtin_bit_cast(bf16x8, w_); })
#define SC_UOP(base, row) ({ const u32x2 lo_ = *(const LAS u32x2*)((base) + (row) * 20 + 4 * kg); u32x4 w_; w_.x = lo_.x; w_.y = lo_.y; w_.z = 0u; w_.w = 0u; __builtin_bit_cast(bf16x8, w_); })
#define SC_COP(v) ({ u32x4 w_; w_.x = pk2((v)[0], (v)[1]); w_.y = pk2((v)[2], (v)[3]); w_.z = 0u; w_.w = 0u; __builtin_bit_cast(bf16x8, w_); })
            f32x4 RH = __builtin_amdgcn_mfma_f32_16x16x32_bf16(SC_JOP(P_CAT(cb), 0), SO0, zf, 0, 0, 0); RH = __builtin_amdgcn_mfma_f32_16x16x32_bf16(SC_JOP(P_CAT(cb), 1), SO1, RH, 0, 0, 0);
            const bf16x8 VO = SC_UOP(P_CVI(cb), 16 * q + x);
            RH = __builtin_amdgcn_mfma_f32_16x16x32_bf16(SC_UOP(P_CBM(cb), x), VO, RH, 0, 0, 0);
            const bf16x8 RO = SC_COP(RH);
            const f32x4 SA = __builtin_amdgcn_mfma_f32_16x16x32_bf16(SC_UOP(P_CTT(cb), x), RO, zf, 0, 0, 0);
            const bf16x8 SAO = SC_COP(SA);
            f32x4 Y = __builtin_amdgcn_mfma_f32_16x16x32_bf16(SC_JOP(P_CRT(cb), 0), SO0, zf, 0, 0, 0); Y = __builtin_amdgcn_mfma_f32_16x16x32_bf16(SC_JOP(P_CRT(cb), 1), SO1, Y, 0, 0, 0);
            Y = __builtin_amdgcn_mfma_f32_16x16x32_bf16(SC_UOP(P_CAY(cb), x), SAO, Y, 0, 0, 0); Y = __builtin_amdgcn_mfma_f32_16x16x32_bf16(SC_UOP(P_CBY(cb), x), VO, Y, 0, 0, 0);
#pragma unroll
            for (int e = 0; e < 4; ++e) (YLh + ((k & 1) ? 2048 : 0))[(dir * 16 + 4 * kg + e) * 64 + 16 * q + x] = (unsigned short)f2bf(Y[e]);
#pragma unroll
            for (int jt = 0; jt < 4; ++jt) {
                ST[jt] = __builtin_amdgcn_mfma_f32_16x16x32_bf16(SC_UOP(P_CBJ(cb), 16 * jt + x), SAO, ST[jt], 0, 0, 0);
                ST[jt] = __builtin_amdgcn_mfma_f32_16x16x32_bf16(SC_UOP(P_CKJ(cb), 16 * jt + x), VO, ST[jt], 0, 0, 0);
                ST[jt] = ST[jt] * *(const LAS f32x4*)(P_CGC(cb) + 16 * jt + 4 * kg);
            }
#undef SC_JOP
#undef SC_UOP
#undef SC_COP
        }
        if (k < 0) {
#pragma unroll
            for (int jt = 0; jt < 4; ++jt) ST[jt] = zf; }
        if (k >= 1) {
            const int cc = k - 1;
            const int t = SC_TOK(p1, cc); bf16* dst = (bf16*)YB + (size_t)(p1 >> 4) * NT * 384 + (size_t)(seqbase + t) * 384 + h * 64 + 4 * q1; const u32x2 w = *(const LAS u32x2*)(YLh + ((cc & 1) ? 2048 : 0) + p1 * 64 + 4 * q1);
            *(u32x2*)dst = w;
        }
        SC_BAR();
        r0 = r1;
      }
    }
#undef SC_LOAD
#undef SC_LOAD0
#undef SC_B0
#undef SC_ROWS
#undef TWLB
}

constexpr int AT_OACC = 0, AT_M = 256 * 68 * 4, AT_L = AT_M + 1024, AT_VT = AT_L + 1024, AT_VT_W = 64 * 36 * 2, AT_BT = AT_VT + 8 * AT_VT_W, AT_END = AT_BT + 18 * 176 * 4;
static_assert(AT_END <= LDS_BYTES - 64 && 17408 + 6 * SCB <= LDS_BYTES - 64, "attention / scan LDS maps");
__device__ __forceinline__ void attn_unit(LAS unsigned char* lds, const bf16* ZB, bf16* HB, const bf16* zero_row, int u, int tid, int lane, int wave) {
    LAS float* OACC = (LAS float*)(lds + AT_OACC); LAS float* MACC = (LAS float*)(lds + AT_M); LAS float* LACC = (LAS float*)(lds + AT_L);
    LAS unsigned* VTw = (LAS unsigned*)(lds + AT_VT + wave * AT_VT_W); LAS unsigned short* VTh = (LAS unsigned short*)VTw; const LAS float* BT = (const LAS float*)(lds + AT_BT);
    const int h = u % 6, rg = u / 6, mg = rg * 256;
    int T, seqbase, t0; seq_of(mg, T, seqbase, t0);
    const bf16* zseq = ZB + (size_t)seqbase * ZW;
    const int qi = lane & 15, kg = lane >> 4;
    for (int br = 0; br < 3; ++br) {
        const int sh = 2 * br, L = T >> sh;
        const LAS float* bt = BT + (br * 6 + h) * 176 + (4 * kg - qi + 15);
        for (int jj = 0; jj < 2; ++jj) {
            const int j = wave * 2 + jj;
            int c, m0;
            if (br == 0) { c = 0; m0 = t0 + 16 * j; } else if (br == 1) { c = j & 3; m0 = (t0 >> 2) + 16 * (j >> 2); } else { c = j; m0 = t0 >> 4; }
            const int tq = ((m0 + qi) << sh) + c;
            const bool edge = (m0 < 64) || (m0 + 96 > L);
            const bf16* qp = zseq + (size_t)tq * ZW + h * 64 + 8 * kg;
            const bf16x8 Q0 = *(const bf16x8*)qp, Q1 = *(const bf16x8*)(qp + 32);
            float lg[10][4];
            float mx = -1e30f;
            bf16x8 Kf[10][2];
#pragma unroll
            for (int jt = 0; jt < 10; ++jt) {
                const int kw = m0 - 64 + 16 * jt + qi; const bool kv = (kw >= 0) && (kw < L);
                const bf16* kp = (kv ? zseq + (size_t)((kw << sh) + c) * ZW : zero_row) + 384 + h * 64 + 8 * kg;
                Kf[jt][0] = *(const bf16x8*)kp; Kf[jt][1] = *(const bf16x8*)(kp + 32);
            }
#pragma unroll
            for (int jt = 0; jt < 10; ++jt) {
                f32x4 s = (f32x4){0.f, 0.f, 0.f, 0.f};
                s = __builtin_amdgcn_mfma_f32_16x16x32_bf16(Kf[jt][0], Q0, s, 0, 0, 0);
                s = __builtin_amdgcn_mfma_f32_16x16x32_bf16(Kf[jt][1], Q1, s, 0, 0, 0);
#pragma unroll
                for (int e = 0; e < 4; ++e) lg[jt][e] = s[e] * 0.125f + bt[16 * jt + e];
            }
            if (edge) {
#pragma unroll
                for (int jt = 0; jt < 10; ++jt)
#pragma unroll
                    for (int e = 0; e < 4; ++e) { const int kw2 = m0 - 64 + 16 * jt + 4 * kg + e; if (!((kw2 >= 0) && (kw2 < L))) lg[jt][e] = -1e30f; }
            }
#pragma unroll
            for (int jt = 0; jt < 10; ++jt)
#pragma unroll
                for (int e = 0; e < 4; ++e) mx = fmaxf(mx, lg[jt][e]);
            mx = fmaxf(mx, __shfl_xor(mx, 16)); mx = fmaxf(mx, __shfl_xor(mx, 32));
            float lsum = 0.f;
#pragma unroll
            for (int jt = 0; jt < 10; ++jt)
#pragma unroll
                for (int e = 0; e < 4; ++e) { const float p = __expf(lg[jt][e] - mx); lg[jt][e] = p; lsum += p; }
            lsum += __shfl_xor(lsum, 16); lsum += __shfl_xor(lsum, 32);
            f32x4 Oa[4];
#pragma unroll
            for (int dt = 0; dt < 4; ++dt) Oa[dt] = (f32x4){0.f, 0.f, 0.f, 0.f};
            u32x4 vxa[2], vxb[2];
#define AT_VLOAD(kt_) do { _Pragma("unroll") for (int u2 = 0; u2 < 2; ++u2) { const int pid = lane + 64 * u2, rp = pid & 15, dc = pid >> 4; \
                    const int kwa = m0 - 64 + 32 * (kt_) + 2 * rp, kwb = kwa + 1; const bool va = (kwa >= 0) && (kwa < L), vb = (kwb >= 0) && (kwb < L); \
                    const bf16* pa_ = va ? zseq + (size_t)((kwa << sh) + c) * ZW : zero_row; const bf16* pb_ = vb ? zseq + (size_t)((kwb << sh) + c) * ZW : zero_row; \
                    vxa[u2] = *(const u32x4*)(pa_ + 768 + h * 64 + 8 * dc); vxb[u2] = *(const u32x4*)(pb_ + 768 + h * 64 + 8 * dc); } } while (0)
            AT_VLOAD(0);
#pragma unroll
            for (int kt = 0; kt < 5; ++kt) {
#pragma unroll
                for (int u2 = 0; u2 < 2; ++u2) {
                    const int pid = lane + 64 * u2, rp = pid & 15, dc = pid >> 4;
                    const u32x4 xa = vxa[u2], xb = vxb[u2];
                    LAS unsigned* wp = VTw + (8 * dc) * 18 + rp;
                    wp[0 * 18] = __builtin_amdgcn_perm(xb.x, xa.x, 0x05040100u); wp[1 * 18] = __builtin_amdgcn_perm(xb.x, xa.x, 0x07060302u);
                    wp[2 * 18] = __builtin_amdgcn_perm(xb.y, xa.y, 0x05040100u); wp[3 * 18] = __builtin_amdgcn_perm(xb.y, xa.y, 0x07060302u);
                    wp[4 * 18] = __builtin_amdgcn_perm(xb.z, xa.z, 0x05040100u); wp[5 * 18] = __builtin_amdgcn_perm(xb.z, xa.z, 0x07060302u);
                    wp[6 * 18] = __builtin_amdgcn_perm(xb.w, xa.w, 0x05040100u); wp[7 * 18] = __builtin_amdgcn_perm(xb.w, xa.w, 0x07060302u);
                }
                if (kt < 4) AT_VLOAD(kt + 1);
                LDS_WAIT();
                u32x4 pw; pw.x = pg8::cvt_pk_bf16(lg[2 * kt][0], lg[2 * kt][1]); pw.y = pg8::cvt_pk_bf16(lg[2 * kt][2], lg[2 * kt][3]); pw.z = pg8::cvt_pk_bf16(lg[2 * kt + 1][0], lg[2 * kt + 1][1]); pw.w = pg8::cvt_pk_bf16(lg[2 * kt + 1][2], lg[2 * kt + 1][3]);
                const bf16x8 Pf = __builtin_bit_cast(bf16x8, pw);
#pragma unroll
                for (int dt = 0; dt < 4; ++dt) {
                    const LAS unsigned short* rp_ = VTh + (16 * dt + qi) * 36 + 4 * kg;
                    const u32x2 lo = *(const LAS u32x2*)rp_, hi = *(const LAS u32x2*)(rp_ + 16);
                    u32x4 aw; aw.x = lo.x; aw.y = lo.y; aw.z = hi.x; aw.w = hi.y;
                    Oa[dt] = __builtin_amdgcn_mfma_f32_16x16x32_bf16(__builtin_bit_cast(bf16x8, aw), Pf, Oa[dt], 0, 0, 0);
                }
                LDS_WAIT();
            }
#undef AT_VLOAD
            const int tok = tq - t0; LAS float* op = OACC + tok * 68 + 4 * kg;
            if (br == 0) {
#pragma unroll
                for (int dt = 0; dt < 4; ++dt) *(LAS f32x4*)(op + 16 * dt) = Oa[dt];
                if (kg == 0) { MACC[tok] = mx; LACC[tok] = lsum; }
            } else {
                const float mo = MACC[tok], lo_ = LACC[tok]; const float mn = fmaxf(mo, mx); const float so = __expf(mo - mn), sc = __expf(mx - mn);
#pragma unroll
                for (int dt = 0; dt < 4; ++dt) { f32x4 o = *(LAS f32x4*)(op + 16 * dt); o = o * so + Oa[dt] * sc; *(LAS f32x4*)(op + 16 * dt) = o; }
                LDS_WAIT();
                if (kg == 0) { MACC[tok] = mn; LACC[tok] = lo_ * so + lsum * sc; }
            }
        }
        __syncthreads();
    }
    {
        const int tok = tid >> 1, half = tid & 1; const float inv = 1.f / LACC[tok]; const LAS float* op = OACC + tok * 68 + 32 * half;
        bf16* dst = HB + (size_t)(mg + tok) * DM + h * 64 + 32 * half;
#pragma unroll
        for (int q = 0; q < 4; ++q) { const f32x4 x0 = *(const LAS f32x4*)(op + 8 * q), x1 = *(const LAS f32x4*)(op + 8 * q + 4);
            u32x4 w; w.x = pk2(x0.x * inv, x0.y * inv); w.y = pk2(x0.z * inv, x0.w * inv); w.z = pk2(x1.x * inv, x1.y * inv); w.w = pk2(x1.z * inv, x1.w * inv);
            *(u32x4*)(dst + 8 * q) = w; }
    }
    __syncthreads();
}
__device__ __forceinline__ int t5_bucket_dev(int rd) {
    const int n = rd < 0 ? -rd : rd; const int ret = rd > 0 ? 16 : 0;
    const int v = n < 8 ? n : (n < 15 ? 8 : (n < 27 ? 9 : (n < 50 ? 10 : (n < 91 ? 11 : (n < 166 ? 12 : (n < 305 ? 13 : (n < 559 ? 14 : 15)))))));
    return ret + v;
}
__device__ __forceinline__ void phase_mixers(LAS unsigned char* lds, const bf16* ZB, float* YB, bf16* HB, CArgs* ap, int l, unsigned* counter, int tid, int lane, int wave) {
#ifdef SPLIT_MIX
    const unsigned long long tsm0_ = __builtin_amdgcn_s_memrealtime();
#endif
#ifndef NO_SCAN
    for (int su = blockIdx.x; su < N_SCAN_UNITS; su += gridDim.x) { scan_unit(lds, ZB, YB, ap, l, su, tid, lane, wave); __syncthreads(); }
#endif
#ifdef SPLIT_MIX
    cg::this_grid().sync();
#ifndef SPLIT_NOSPIN
    { const unsigned long long t1_ = __builtin_amdgcn_s_memrealtime(); const unsigned long long dt_ = t1_ - tsm0_; while (__builtin_amdgcn_s_memrealtime() - t1_ < dt_) __builtin_amdgcn_s_sleep(8); cg::this_grid().sync(); }
#endif
#endif
    if (l == 0 && (int)blockIdx.x >= N_SCAN_UNITS && (int)gridDim.x > N_SCAN_UNITS) {
        convert_weights(lds, ap, 1, 2, ((int)blockIdx.x - N_SCAN_UNITS) * 8 + wave, ((int)gridDim.x - N_SCAN_UNITS) * 8, lane, wave);
        __syncthreads(); }
    {   LAS float* BT = (LAS float*)(lds + AT_BT); LAS float* rb = (LAS float*)(lds + LDS_BYTES - 1024);
        if (tid < 192) rb[tid] = ap->in[2][tid];
        __syncthreads();
        for (int i = tid; i < 3 * 6 * 176; i += 512) { const int br = i / (6 * 176), rem = i % (6 * 176), h = rem / 176, ri = rem % 176; const int rel = ri - 79;
            BT[(br * 6 + h) * 176 + ri] = (rel >= -64 && rel <= 64) ? rb[t5_bucket_dev(rel * (1 << (2 * br))) * 6 + h] : -1e30f; } }
    __syncthreads();
    LAS int* flag = (LAS int*)(lds + LDS_BYTES - 16);
#ifndef ATTN_REPS
#define ATTN_REPS 1
#endif
#pragma unroll 1
    for (int rep = 0; rep < ATTN_REPS; ++rep)
    for (;;) {
        if (tid == 0) *flag = (int)atomicAdd(counter + 16 * rep, 1u);
        __syncthreads();
        const int u = *flag;
        __syncthreads();
        if (u >= N_ATTN_UNITS) break;
#ifndef NO_ATTN
        attn_unit(lds, ZB, HB, (const bf16*)ap->ws, u, tid, lane, wave);
#endif
    }
}

constexpr int FN_AUPT = 0, FN_GUPT = 768 * 80, FN_END = FN_GUPT + 384 * 144;
static_assert(FN_END + 4992 * 4 <= LDS_BYTES - 64, "final-phase LDS map");
__device__ __forceinline__ void phase_final(LAS unsigned char* lds, const bf16* ZB, const float* YB, bf16* HB, CArgs* ap, int l, int gw, int NGW, int tid, int lane, int wave) {
    LAS unsigned short* AUPT = (LAS unsigned short*)(lds + FN_AUPT); LAS unsigned short* GUPT = (LAS unsigned short*)(lds + FN_GUPT);
    {   const float* aup = ap->in[16] + (size_t)l * 2 * 32 * 384;
#pragma unroll 1
        for (int i0 = tid; i0 < 2 * 32 * 384; i0 += 512 * 8) { float v8[8];
#pragma unroll
            for (int k = 0; k < 8; ++k) v8[k] = aup[i0 + 512 * k];
#pragma unroll
            for (int k = 0; k < 8; ++k) { const int i = i0 + 512 * k; const int c = i % 384, r = (i / 384) & 31, d = i / (384 * 32); AUPT[(d * 384 + c) * 40 + r] = (unsigned short)f2bf(v8[k]); } }
        const float* gup = ap->in[17] + (size_t)l * 64 * 384;
#pragma unroll 1
        for (int i0 = tid; i0 < 64 * 384; i0 += 512 * 8) { float v8[8];
#pragma unroll
            for (int k = 0; k < 8; ++k) v8[k] = gup[i0 + 512 * k];
#pragma unroll
            for (int k = 0; k < 8; ++k) { const int i = i0 + 512 * k; const int c = i % 384, r = i / 384; GUPT[c * 72 + r] = (unsigned short)f2bf(v8[k]); } } }
    LAS float* PL = (LAS float*)(lds + FN_END);
    {   const float* src[9] = {ap->in[12] + l * 1280, ap->in[15] + l * 768, ap->in[19] + l * 384, ap->in[20] + l * 384, ap->in[21] + l * 384, ap->in[22] + l * 384, ap->in[9] + l * 384, ap->in[10] + l * 768, ap->in[11] + l * 256};
        const int cnt[9] = {1280, 768, 384, 384, 384, 384, 384, 768, 256}; int off = 0;
#pragma unroll
        for (int k = 0; k < 9; ++k) { for (int i = tid; i < cnt[k]; i += 512) PL[off + i] = src[k][i]; off += cnt[k]; } }
    __syncthreads();
    const LAS float* mu = PL; const LAS float* a0 = PL + 1280; const LAS float* k_a = PL + 2048; const LAS float* r_k = PL + 2432; const LAS float* lnw = PL + 2816; const LAS float* lnb = PL + 3200;
    const LAS float* ga = PL + 3584; const LAS float* cw = PL + 3968; const LAS float* cgn = PL + 4736;
    const u32x4 z4 = (u32x4){0u, 0u, 0u, 0u}; const u32x2 z2 = (u32x2){0u, 0u};
#pragma unroll 1
    for (int tile = gw; tile < NT / 16; tile += NGW) {
        int lane_l = lane; asm volatile("" : "+v"(lane_l));
        const int tk = lane_l & 15, kg = lane_l >> 4;
        const int m = tile * 16 + tk; int T, seqbase, t; seq_of(m, T, seqbase, t); const bool hp = t > 0, hn = t < T - 1;
        const bf16* zr = ZB + (size_t)m * ZW;
        const bf16* zrp = hp ? zr - ZW : (const bf16*)ap->ws; const bf16* zrn = hn ? zr + ZW : (const bf16*)ap->ws;
        bf16* hrow = HB + (size_t)m * DM;
        {
            float ss = 0.f, rs = 0.f;
#pragma unroll 1
            for (int pass = 0; pass < 2; ++pass) {
#pragma unroll 12
                for (int e = 0; e < 12; ++e) { float f[8]; unpack8(*(const u32x4*)(hrow + 32 * e + 8 * kg), f);
                    const f32x4 g0 = *(const LAS f32x4*)(ga + 32 * e + 8 * kg), g1 = *(const LAS f32x4*)(ga + 32 * e + 8 * kg + 4);
#pragma unroll
                    for (int q = 0; q < 8; ++q) ss += f[q] * f[q];
#pragma unroll
                    for (int q = 0; q < 4; ++q) { f[q] *= rs * g0[q]; f[4 + q] *= rs * g1[q]; }
                    if (pass == 1) *(u32x4*)(hrow + 32 * e + 8 * kg) = pack8(f); }
                if (pass == 0) { ss += __shfl_xor(ss, 16); ss += __shfl_xor(ss, 32); rs = rsqrtf(ss * (1.f / 384.f) + 1e-6f); }
            }
        }
        {
            float ss = 0.f;
#pragma unroll 4
            for (int e = 0; e < 8; ++e) { const int c0 = 32 * e + 8 * kg;
                float bg[8], c1[8], h1[8], c0v[8], h0[8], c2[8], h2[8], f[8];
                unpack8(*(const u32x4*)(zr + 1152 + c0), bg); unpack8(*(const u32x4*)(zr + 1408 + c0), c1); unpack8(*(const u32x4*)(zr + 1664 + c0), h1);
                unpack8(*(const u32x4*)(zrp + 1408 + c0), c0v); unpack8(*(const u32x4*)(zrp + 1664 + c0), h0);
                unpack8(*(const u32x4*)(zrn + 1408 + c0), c2); unpack8(*(const u32x4*)(zrn + 1664 + c0), h2);
#pragma unroll
                for (int q = 0; q < 8; ++q) f[q] = bg[q] * (c0v[q] * h0[q] * cw[c0 + q] + c1[q] * h1[q] * cw[256 + c0 + q] + c2[q] * h2[q] * cw[512 + c0 + q]);
                const u32x4 w = pack8(f); float g[8]; unpack8(w, g);
#pragma unroll
                for (int q = 0; q < 8; ++q) ss += g[q] * g[q];
                *(u32x4*)(hrow + 384 + c0) = w; }
            ss += __shfl_xor(ss, 16); ss += __shfl_xor(ss, 32); const float rs = rsqrtf(ss * (1.f / 256.f) + 1e-6f);
#pragma unroll 8
            for (int e = 0; e < 8; ++e) { const int c0 = 32 * e + 8 * kg; float f[8]; unpack8(*(const u32x4*)(hrow + 384 + c0), f);
#pragma unroll
                for (int q = 0; q < 8; ++q) f[q] *= rs * cgn[c0 + q];
                *(u32x4*)(hrow + 384 + c0) = pack8(f); }
        }
        bf16x8 Bad, Bg0, Bg1;
        {   const int ca = 3104 + 8 * kg; float fc[8], fp[8], fn[8], x[8];
            unpack8(*(const u32x4*)(zr + ca), fc); unpack8(*(const u32x4*)(zrp + ca), fp); unpack8(*(const u32x4*)(zrn + ca), fn);
#pragma unroll
            for (int q = 0; q < 8; ++q) x[q] = fc[q] + (0.5f * (fp[q] + fn[q]) - fc[q]) * mu[1184 + 8 * kg + q];
            Bad = __builtin_bit_cast(bf16x8, pack8(x));
#pragma unroll
            for (int ks = 0; ks < 2; ++ks) { const int cg2 = 3136 + 32 * ks + 8 * kg;
                unpack8(*(const u32x4*)(zr + cg2), fc); unpack8(*(const u32x4*)(zrp + cg2), fp); unpack8(*(const u32x4*)(zrn + cg2), fn);
#pragma unroll
                for (int q = 0; q < 8; ++q) x[q] = sigm(fc[q] + (0.5f * (fp[q] + fn[q]) - fc[q]) * mu[1216 + 32 * ks + 8 * kg + q]);
                if (ks == 0) Bg0 = __builtin_bit_cast(bf16x8, pack8(x)); else Bg1 = __builtin_bit_cast(bf16x8, pack8(x)); }
        }
#pragma unroll 1
        for (int h = 0; h < 6; ++h) {
            float bsum = 0.f, ysum = 0.f, ysq = 0.f;
            const f32x4 zf = (f32x4){0.f, 0.f, 0.f, 0.f};
            const bf16* ybA = (const bf16*)YB + (size_t)m * 384; const bf16* ybB = ybA + (size_t)NT * 384;
            u32x4 Lr[2][3], Lk[2][3], Lv[2][3], Ly[2][2];
#pragma unroll
            for (int p2 = 0; p2 < 2; ++p2) { const int c8 = h * 64 + 32 * p2 + 8 * kg;
                Lr[p2][0] = *(const u32x4*)(zr + 1920 + c8); Lr[p2][1] = *(const u32x4*)(zrp + 1920 + c8); Lr[p2][2] = *(const u32x4*)(zrn + 1920 + c8);
                Lk[p2][0] = *(const u32x4*)(zr + 2304 + c8); Lk[p2][1] = *(const u32x4*)(zrp + 2304 + c8); Lk[p2][2] = *(const u32x4*)(zrn + 2304 + c8);
                Lv[p2][0] = *(const u32x4*)(zr + 2688 + c8); Lv[p2][1] = *(const u32x4*)(zrp + 2688 + c8); Lv[p2][2] = *(const u32x4*)(zrn + 2688 + c8);
                Ly[p2][0] = *(const u32x4*)(ybA + c8); Ly[p2][1] = *(const u32x4*)(ybB + c8); }
#pragma unroll
            for (int p2 = 0; p2 < 2; ++p2) {
                const int cbase = h * 64 + 32 * p2, c8 = cbase + 8 * kg, rowA = cbase + 8 * (tk >> 2) + (tk & 3), rowB = rowA + 4;
                const bf16x8 Wa0A = *(const LAS bf16x8*)(AUPT + rowA * 40 + 8 * kg), Wa0B = *(const LAS bf16x8*)(AUPT + rowB * 40 + 8 * kg);
                const bf16x8 Wa1A = *(const LAS bf16x8*)(AUPT + (384 + rowA) * 40 + 8 * kg), Wa1B = *(const LAS bf16x8*)(AUPT + (384 + rowB) * 40 + 8 * kg);
                const f32x4 A0a = __builtin_amdgcn_mfma_f32_16x16x32_bf16(Wa0A, Bad, zf, 0, 0, 0), A0b = __builtin_amdgcn_mfma_f32_16x16x32_bf16(Wa0B, Bad, zf, 0, 0, 0);
                const f32x4 A1a = __builtin_amdgcn_mfma_f32_16x16x32_bf16(Wa1A, Bad, zf, 0, 0, 0), A1b = __builtin_amdgcn_mfma_f32_16x16x32_bf16(Wa1B, Bad, zf, 0, 0, 0);
                float rc[8], rp[8], rn[8], kc[8], kp[8], kn[8], ya[8], yb2[8];
                unpack8(Lr[p2][0], rc); unpack8(Lr[p2][1], rp); unpack8(Lr[p2][2], rn);
                unpack8(Lk[p2][0], kc); unpack8(Lk[p2][1], kp); unpack8(Lk[p2][2], kn);
                unpack8(Ly[p2][0], ya); unpack8(Ly[p2][1], yb2);
#pragma unroll
                for (int i = 0; i < 8; ++i) {
                    const float s0 = (i < 4) ? A0a[i & 3] : A0b[i & 3], s1 = (i < 4) ? A1a[i & 3] : A1b[i & 3];
                    const float rr = rc[i] + (0.5f * (rp[i] + rn[i]) - rc[i]) * mu[c8 + i], kk = kc[i] + (0.5f * (kp[i] + kn[i]) - kc[i]) * mu[384 + c8 + i];
                    const float av0 = sigm(s0 + a0[c8 + i]), av1 = sigm(s1 + a0[384 + c8 + i]); const float ka = k_a[c8 + i];
                    const float kd = kk * ((1.f + (av0 - 1.f) * ka) + (1.f + (av1 - 1.f) * ka));
                    const float y = ya[i] + yb2[i];
                    bsum += rr * kd * r_k[c8 + i]; ysum += y; ysq += y * y;
                }
            }
            bsum += __shfl_xor(bsum, 16); bsum += __shfl_xor(bsum, 32); ysum += __shfl_xor(ysum, 16); ysum += __shfl_xor(ysum, 32); ysq += __shfl_xor(ysq, 16); ysq += __shfl_xor(ysq, 32);
            const float mean = ysum * (1.f / 64.f); const float var = fmaxf(ysq * (1.f / 64.f) - mean * mean, 0.f);
            const float rstd = rsqrtf(var + 64e-5f);
#pragma unroll
            for (int p2 = 0; p2 < 2; ++p2) {
                const int cbase = h * 64 + 32 * p2, c8 = cbase + 8 * kg, rowA = cbase + 8 * (tk >> 2) + (tk & 3), rowB = rowA + 4;
                const bf16x8 Wg0A = *(const LAS bf16x8*)(GUPT + rowA * 72 + 8 * kg), Wg1A = *(const LAS bf16x8*)(GUPT + rowA * 72 + 32 + 8 * kg);
                const bf16x8 Wg0B = *(const LAS bf16x8*)(GUPT + rowB * 72 + 8 * kg), Wg1B = *(const LAS bf16x8*)(GUPT + rowB * 72 + 32 + 8 * kg);
                f32x4 Ga = __builtin_amdgcn_mfma_f32_16x16x32_bf16(Wg0A, Bg0, zf, 0, 0, 0); Ga = __builtin_amdgcn_mfma_f32_16x16x32_bf16(Wg1A, Bg1, Ga, 0, 0, 0);
                f32x4 Gb = __builtin_amdgcn_mfma_f32_16x16x32_bf16(Wg0B, Bg0, zf, 0, 0, 0); Gb = __builtin_amdgcn_mfma_f32_16x16x32_bf16(Wg1B, Bg1, Gb, 0, 0, 0);
                float vc[8], vp[8], vn[8], ya[8], yb2[8], o[8];
                unpack8(Lv[p2][0], vc); unpack8(Lv[p2][1], vp); unpack8(Lv[p2][2], vn);
                unpack8(Ly[p2][0], ya); unpack8(Ly[p2][1], yb2);
#pragma unroll
                for (int i = 0; i < 8; ++i) { const float v = vc[i] + (0.5f * (vp[i] + vn[i]) - vc[i]) * mu[768 + c8 + i]; const float g = (i < 4) ? Ga[i & 3] : Gb[i & 3];
                    o[i] = (((ya[i] + yb2[i]) - mean) * rstd * lnw[c8 + i] + lnb[c8 + i] + bsum * v) * g; }
                *(u32x4*)(hrow + 640 + c8) = pack8(o);
            }
        }
    }
}

#define XB_TMO      128
#define XB_XCNT(j)  (256  + 64 * (j))
#define XB_XSUB(j)  (1280 + 64 * (j))
#define XB_XGEN(j)  (2304 + 64 * (j))
#define XB_TOP      3328
#define XB_TOPGEN   3392
#define XCD_BAR_WORDS 3456
#define XB_SPIN_CAP (1u << 18)

__device__ __forceinline__ unsigned xb_ld(unsigned* p)              { return __hip_atomic_load(p, __ATOMIC_RELAXED, __HIP_MEMORY_SCOPE_AGENT); }
__device__ __forceinline__ unsigned xb_add(unsigned* p, unsigned v) { return __hip_atomic_fetch_add(p, v, __ATOMIC_RELAXED, __HIP_MEMORY_SCOPE_AGENT); }
__device__ __forceinline__ unsigned xb_xcc_id() { return (unsigned)__builtin_amdgcn_s_getreg((3 << 11) | 20) & 0xFu; }
#define XB_SPIN(cond, bar) do { unsigned _sp = 0; while (cond) { __builtin_amdgcn_s_sleep(1); \
    if ((++_sp & 255u) == 0u) { if (xb_ld(&(bar)[XB_TMO])) break; if (_sp > XB_SPIN_CAP) { atomicAdd(&(bar)[XB_TMO], 1u); break; } } } } while (0)

struct XcdBarrier {
    unsigned* bar; unsigned x;
    volatile LAS unsigned* st;
};

__device__ __forceinline__ XcdBarrier xcd_barrier_post(unsigned* bar, volatile LAS unsigned* st) {
    XcdBarrier b; b.bar = bar; b.x = xb_xcc_id(); b.st = st;
    if (threadIdx.x == 0) (void)xb_add(&bar[XB_XCNT(b.x)], 1u);
    return b;
}
__device__ __forceinline__ void xcd_barrier_complete(unsigned* bar, unsigned x, unsigned& nloc, unsigned& nx) {
    const unsigned G = gridDim.x * gridDim.y * gridDim.z;
    unsigned sum, cnt, mine, sp = 0u;
    for (;;) {
        sum = 0u; cnt = 0u; mine = 0u;
#pragma unroll
        for (unsigned j = 0; j < 16; ++j) { const unsigned c = xb_ld(&bar[XB_XCNT(j)]); sum += c; cnt += (c > 0u) ? 1u : 0u; mine = (j == x) ? c : mine; }
        if (sum == G) break;
        __builtin_amdgcn_s_sleep(1);
        if ((++sp & 255u) == 0u) { if (xb_ld(&bar[XB_TMO])) break; if (sp > XB_SPIN_CAP) { atomicAdd(&bar[XB_TMO], 1u); break; } }
    }
    nloc = mine > 0u ? mine : 1u; nx = cnt > 0u ? cnt : 1u;
}

__device__ __forceinline__ void xcd_barrier(const XcdBarrier& b) {
    asm volatile("s_waitcnt vmcnt(0)" ::: "memory");
    __syncthreads();
    if (threadIdx.x == 0) {
        unsigned* bar = b.bar;
        __builtin_amdgcn_s_waitcnt(0);
        unsigned nloc = b.st[0], nx = b.st[1];
        if (nloc == 0u) { xcd_barrier_complete(bar, b.x, nloc, nx); b.st[0] = nloc; b.st[1] = nx; }
        const unsigned old = xb_add(&bar[XB_XSUB(b.x)], 1u);
        const unsigned gen = old / nloc;
        if (old + 1u == (gen + 1u) * nloc) {
            __builtin_amdgcn_fence(__ATOMIC_RELEASE, "agent");
            asm volatile("s_waitcnt vmcnt(0)" ::: "memory");
            const unsigned og = xb_add(&bar[XB_TOP], 1u);
            const unsigned tg = og / nx;
            if (og + 1u == (tg + 1u) * nx) xb_add(&bar[XB_TOPGEN], 1u);
            else XB_SPIN(xb_ld(&bar[XB_TOPGEN]) == tg, bar);
            __builtin_amdgcn_fence(__ATOMIC_ACQUIRE, "agent");
            xb_add(&bar[XB_XGEN(b.x)], 1u);
            asm volatile("s_waitcnt vmcnt(0)" ::: "memory");
        } else {
            XB_SPIN(xb_ld(&bar[XB_XGEN(b.x)]) == gen, bar);
            __builtin_amdgcn_fence(__ATOMIC_ACQUIRE, "agent");
            asm volatile("s_waitcnt vmcnt(0)" ::: "memory");
        }
    }
    __syncthreads();
}

#define WSP(off) (ap->ws + (off))
#ifndef PROBE_MASK
#define PROBE_MASK 0
#endif
#define PH_BEGIN(id) unsigned long long t0_ = 0; if (PROBE_MASK & (1 << (id))) t0_ = __builtin_amdgcn_s_memrealtime()
#define PH_END(id) do { if (PROBE_MASK & (1 << (id))) { const unsigned long long t1_ = __builtin_amdgcn_s_memrealtime(); const unsigned long long dt_ = t1_ - t0_; \
    while (__builtin_amdgcn_s_memrealtime() - t1_ < dt_) __builtin_amdgcn_s_sleep(8); grid.sync(); } } while (0)
__global__ void __launch_bounds__(512, 2) mega_fwd(Args a_unused) {
    extern __shared__ __attribute__((aligned(16))) unsigned char lds_raw[];
    LAS unsigned char* lds = (LAS unsigned char*)lds_raw;
    cg::grid_group grid = cg::this_grid();
    {   volatile LAS unsigned* st_ = (volatile LAS unsigned*)(lds + LDS_BYTES - 48);
        if (threadIdx.x < 2) st_[threadIdx.x] = 0u;
        __syncthreads();
        CArgs* ap = KARGS(); (void)xcd_barrier_post((unsigned*)(ap->ws + 16384u), st_); }
#define GSYNC() do { CArgs* apb_ = KARGS(); XcdBarrier b_; b_.bar = (unsigned*)(apb_->ws + 16384u); b_.x = xb_xcc_id(); b_.st = (volatile LAS unsigned*)(lds + LDS_BYTES - 48); xcd_barrier(b_); } while (0)
#define IDS() int tid_l_ = threadIdx.x; asm volatile("" : "+v"(tid_l_)); const int tid = tid_l_, lane = tid & 63, wave = __builtin_amdgcn_readfirstlane(tid >> 6); const int G = gridDim.x, gw = blockIdx.x * 8 + wave, NGW = G * 8; (void)tid; (void)lane; (void)gw; (void)NGW; (void)G
#ifdef ONLY_FINAL
    {   IDS(); CArgs* ap = KARGS(); const int l = 0;
        phase_final(lds, (const bf16*)WSP(WS_ZB), (const float*)WSP(WS_YB), (bf16*)WSP(WS_HB), ap, l, gw, NGW, tid, lane, wave); }
    return;
#endif
#ifdef ONLY_MIX
    {   IDS(); CArgs* ap = KARGS(); const int l = 0;
        phase_mixers(lds, (const bf16*)WSP(WS_ZB), (float*)WSP(WS_YB), (bf16*)WSP(WS_HB), ap, l, (unsigned*)WSP(CNT_OFF) + 64 * l, tid, lane, wave); }
    return;
#endif
    { PH_BEGIN(0);
    {   IDS(); CArgs* ap = KARGS();
        phase_prologue(lds, ap, gw, NGW, lane, wave);
        phase_norm0(ap->in[0], ap->in[1], ap->in[3], (bf16*)WSP(WS_HB), gw, NGW, lane); }
    grid.sync(); PH_END(0); }
#pragma unroll 1
    for (int l = 0; l < 2; ++l) {
        { PH_BEGIN(1);
        {   IDS(); CArgs* ap = KARGS();
            pg8::Gemm g{(bf16*)WSP(WS_HB), (bf16*)WSP(WS_WIN) + (size_t)l * ZWP * DM, NT, ZWP, DM}; pg8::StaticOrder S; S.init(NT, ZWP, G, (int)blockIdx.x);
            pg8::EpiMy<0> E{(bf16*)WSP(WS_ZB), ZW, ZW, nullptr};
            pg8::gemm_phase<pg8::EpiMy<0>, pg8::StaticOrder, true, true>(lds, g, S, E); }
        GSYNC(); PH_END(1); }
        { PH_BEGIN(2);
        {   IDS(); CArgs* ap = KARGS();
#ifndef NO_MIX
            phase_mixers(lds, (const bf16*)WSP(WS_ZB), (float*)WSP(WS_YB), (bf16*)WSP(WS_HB), ap, l, (unsigned*)WSP(CNT_OFF) + 64 * l, tid, lane, wave);
#endif
        }
        GSYNC(); PH_END(2); }
        { PH_BEGIN(3);
        {   IDS(); CArgs* ap = KARGS();
#ifndef NO_FINAL
            phase_final(lds, (const bf16*)WSP(WS_ZB), (const float*)WSP(WS_YB), (bf16*)WSP(WS_HB), ap, l, gw, NGW, tid, lane, wave);
#endif
        }
        GSYNC(); PH_END(3); }
        { PH_BEGIN(4);
        {   IDS(); CArgs* ap = KARGS();
            pg8::Gemm g{(bf16*)WSP(WS_HB), (bf16*)WSP(WS_WOUT) + (size_t)l * DM * DM, NT, DM, DM}; pg8::StaticOrder S; S.init(NT, DM, G, (int)blockIdx.x);
            pg8::EpiMy<0> E{(bf16*)WSP(WS_RAW), DM, DM, nullptr};
            pg8::gemm_phase<pg8::EpiMy<0>, pg8::StaticOrder, true, true>(lds, g, S, E); }
        GSYNC(); PH_END(4); }
        { PH_BEGIN(5);
        {   IDS(); CArgs* ap = KARGS();
            phase_resid(ap->in[0], ap->in[1], l == 0, ap->out, (const bf16*)WSP(WS_RAW), ap->in[4] + l * DM, ap->in[5] + l * DM, (bf16*)WSP(WS_HB), gw, NGW, lane); }
        GSYNC(); PH_END(5); }
        { PH_BEGIN(6);
        {   IDS(); CArgs* ap = KARGS();
            pg8::Gemm g{(bf16*)WSP(WS_HB), (bf16*)WSP(WS_W1) + (size_t)l * FFD * DM, NT, FFD, DM}; pg8::StaticOrder S; S.init(NT, FFD, G, (int)blockIdx.x);
            pg8::EpiMy<1> E{(bf16*)WSP(WS_HID), FFD, FFD, nullptr};
            pg8::gemm_phase<pg8::EpiMy<1>, pg8::StaticOrder, true, true>(lds, g, S, E); }
        GSYNC(); PH_END(6); }
        { PH_BEGIN(7);
        {   IDS(); CArgs* ap = KARGS();
            pg8::Gemm g{(bf16*)WSP(WS_HID), (bf16*)WSP(WS_W2) + (size_t)l * DM * FFD, NT, DM, FFD}; pg8::StaticOrder S; S.init(NT, DM, G, (int)blockIdx.x);
            pg8::EpiMy<0> E{(bf16*)WSP(WS_HB), DM, DM, nullptr};
            pg8::gemm_phase<pg8::EpiMy<0>, pg8::StaticOrder, true, true>(lds, g, S, E); }
        GSYNC(); PH_END(7); }
        { PH_BEGIN(8);
        {   IDS(); CArgs* ap = KARGS();
            phase_resid(ap->in[0], ap->in[1], false, ap->out, (const bf16*)WSP(WS_HB), ap->in[6] + l * DM, (l == 0) ? ap->in[3] + DM : nullptr, (bf16*)WSP(WS_HB), gw, NGW, lane); }
        if (l == 0) GSYNC();
        PH_END(8); }
    }
}

extern "C" void kernel_launch(void* const* d_in, const int* in_sizes, int n_in, void* d_out, int out_size, void* d_ws, size_t ws_size, hipStream_t stream) {
    static int grid = 0;
    if (grid == 0) {
        if (n_in != 25 || out_size != NT * DM || ws_size < WS_END) { fprintf(stderr, "kernel_launch: unexpected shapes (n_in %d, out %d, ws %zu)\n", n_in, out_size, ws_size); grid = -1; return; }
        int dev = 0, cus = 0, per_cu = 0;
        if (hipGetDevice(&dev) != hipSuccess || hipDeviceGetAttribute(&cus, hipDeviceAttributeMultiprocessorCount, dev) != hipSuccess) { grid = -1; return; }
        if (hipFuncSetAttribute((const void*)mega_fwd, hipFuncAttributeMaxDynamicSharedMemorySize, LDS_BYTES) != hipSuccess) { fprintf(stderr, "kernel_launch: hipFuncSetAttribute failed\n"); grid = -1; return; }
        if (hipOccupancyMaxActiveBlocksPerMultiprocessor(&per_cu, (const void*)mega_fwd, 512, LDS_BYTES) != hipSuccess || per_cu < 1) { fprintf(stderr, "kernel_launch: occupancy query says %d\n", per_cu); per_cu = 1; }
        (void)hipGetLastError();
        grid = cus;
    }
    if (grid < 0) return;
    (void)hipMemsetAsync(d_ws, 0, WS_CTLB, stream);
    Args a{};
    for (int i = 0; i < 25; ++i) a.in[i] = (const float*)d_in[i];
    a.out = (float*)d_out; a.ws = (unsigned char*)d_ws;
    void* args[] = {&a};
    const hipError_t e = hipLaunchCooperativeKernel((const void*)mega_fwd, dim3(grid), dim3(512), args, LDS_BYTES, stream);
    if (e != hipSuccess) fprintf(stderr, "kernel_launch: cooperative launch failed: %s (grid %d)\n", hipGetErrorString(e), grid);
}
```
